# Optimizing an MI355X kernel written in HIP

```python
import jax, jax.numpy as jnp
from jax import lax
import numpy as np

D_MODEL = 1024
BATCH = 16
SEQ = 4096
DEPTH = 4

CHUNK = 64
BRANCH_W = 512
N_BRANCH = 3
EPS = 1e-6
SG_BLOCK = 128
SG_GROUPS = 4
SG_GROUP_W = BRANCH_W // SG_GROUPS
MLA_HEADS = 8
MLA_NOPE = 64
MLA_ROPE = 32
MLA_QK = MLA_NOPE + MLA_ROPE
MLA_V = 64
MLA_Q_RANK = 256
MLA_KV_RANK = 128
ROPE_THETA = 10000.0
Q_BLOCK = 128
GLA_HEADS = 4
GLA_DK = 64
GLA_DV = 128
GLA_GATE_RANK = 16
GLA_TAU = 16.0

SPLITS = (BRANCH_W, BRANCH_W, BRANCH_W,
          MLA_Q_RANK, MLA_KV_RANK, MLA_ROPE, MLA_HEADS * MLA_V,
          GLA_HEADS * GLA_DK, GLA_HEADS * GLA_DK, GLA_HEADS * GLA_DV,
          GLA_GATE_RANK, GLA_HEADS * GLA_DV,
          N_BRANCH * D_MODEL)
IN_COLS = sum(SPLITS)

kernel_name = 'hybrid_gmlp_mla_gla_gated_merge'


def _rmsnorm(x, g):
    x32 = x.astype(jnp.float32)
    y = x32 * lax.rsqrt(jnp.mean(x32 * x32, axis=-1, keepdims=True) + EPS)
    return (y * g.astype(jnp.float32)).astype(x.dtype)


def _layernorm(x, g, b):
    x32 = x.astype(jnp.float32)
    mu = jnp.mean(x32, axis=-1, keepdims=True)
    xc = x32 - mu
    y = xc * lax.rsqrt(jnp.mean(xc * xc, axis=-1, keepdims=True) + EPS)
    return (y * g.astype(jnp.float32) + b.astype(jnp.float32)).astype(x.dtype)


def _split_cols(proj):
    idx = np.cumsum(np.array(SPLITS))[:-1].tolist()
    return jnp.split(proj, idx, axis=-1)


def _rope_tables(positions):
    half = MLA_ROPE // 2
    inv = 1.0 / (ROPE_THETA ** (jnp.arange(half, dtype=jnp.float32) * 2.0 / MLA_ROPE))
    ang = positions.astype(jnp.float32)[..., None] * inv
    return jnp.cos(ang)[:, :, None, :], jnp.sin(ang)[:, :, None, :]


def _apply_rope(x, cos, sin):
    half = MLA_ROPE // 2
    x32 = x.astype(jnp.float32)
    x1, x2 = x32[..., :half], x32[..., half:]
    return jnp.concatenate([x1 * cos - x2 * sin, x1 * sin + x2 * cos], axis=-1).astype(x.dtype)


def _spatial_gating(u, v, z, ln_g, ln_b, w_s, b_s):
    bn, s, _ = u.shape
    u = jax.nn.gelu(u)
    v = _layernorm(jax.nn.gelu(v), ln_g, ln_b)
    nb = s // SG_BLOCK
    vb = v.reshape(bn, nb, SG_BLOCK, SG_GROUPS, SG_GROUP_W)
    cid = jnp.arange(SG_BLOCK) // CHUNK
    mask = cid[:, None] >= cid[None, :]
    w = jnp.where(mask[None], w_s, jnp.zeros_like(w_s))
    sv = jnp.einsum('gij,bnjgc->bnigc', w, vb) + b_s.T[None, None, :, :, None]
    return u * sv.reshape(bn, s, BRANCH_W) * jax.nn.silu(z)


def _chunk_causal_attention(q, k, v):
    bn, s, h, dq = q.shape
    dv = v.shape[-1]
    nb = s // Q_BLOCK
    scale = dq ** -0.5
    qb = q.reshape(bn, nb, Q_BLOCK, h, dq).transpose(1, 0, 3, 2, 4)
    kh = k.transpose(0, 2, 1, 3)
    vh = v.transpose(0, 2, 1, 3)
    k_chunk = jnp.arange(s) // CHUNK

    def one_block(args):
        qblk, bi = args
        sc = jnp.einsum('bhqd,bhkd->bhqk', qblk, kh).astype(jnp.float32) * scale
        q_chunk = (bi * Q_BLOCK + jnp.arange(Q_BLOCK)) // CHUNK
        mask = k_chunk[None, :] <= q_chunk[:, None]
        sc = jnp.where(mask, sc, -jnp.inf)
        p = jax.nn.softmax(sc, axis=-1)
        return jnp.einsum('bhqk,bhkd->bhqd', p.astype(vh.dtype), vh)

    out = lax.map(one_block, (qb, jnp.arange(nb)))
    return out.transpose(1, 0, 3, 2, 4).reshape(bn, s, h, dv)


def _mla(c_q, c_kv, k_r, z, cq_g, ckv_g, w_uq, w_ukv, q_g, k_g, cos, sin):
    bn, s, _ = c_q.shape
    q = (_rmsnorm(c_q, cq_g) @ w_uq).reshape(bn, s, MLA_HEADS, MLA_QK)
    kv = (_rmsnorm(c_kv, ckv_g) @ w_ukv).reshape(bn, s, MLA_HEADS, MLA_NOPE + MLA_V)
    k_nope, v = kv[..., :MLA_NOPE], kv[..., MLA_NOPE:]
    k_rope = jnp.broadcast_to(k_r[:, :, None, :], (bn, s, MLA_HEADS, MLA_ROPE))
    k = jnp.concatenate([k_nope, k_rope], axis=-1)
    q = _rmsnorm(q, q_g)
    k = _rmsnorm(k, k_g)
    q = jnp.concatenate([q[..., :MLA_NOPE], _apply_rope(q[..., MLA_NOPE:], cos, sin)], axis=-1)
    k = jnp.concatenate([k[..., :MLA_NOPE], _apply_rope(k[..., MLA_NOPE:], cos, sin)], axis=-1)
    o = _chunk_causal_attention(q, k, v)
    return o.reshape(bn, s, MLA_HEADS * MLA_V) * jax.nn.silu(z)


def _gla(q, k, v, g_lr, z, w_gu, b_gu, o_g):
    bn, s, _ = q.shape
    n = s // CHUNK
    f32 = jnp.float32
    qc = q.astype(f32).reshape(bn, n, CHUNK, GLA_HEADS, GLA_DK) * (GLA_DK ** -0.5)
    kc = k.astype(f32).reshape(bn, n, CHUNK, GLA_HEADS, GLA_DK)
    vc = v.astype(f32).reshape(bn, n, CHUNK, GLA_HEADS, GLA_DV)
    log_a = jax.nn.log_sigmoid((g_lr @ w_gu + b_gu).astype(f32)) / GLA_TAU
    log_a = log_a.reshape(bn, n, CHUNK, GLA_HEADS, GLA_DK)
    b = jnp.cumsum(log_a, axis=2)
    b_last = b[:, :, -1]
    q_t = qc * jnp.exp(b)
    k_t = kc * jnp.exp(-b)
    k_s = kc * jnp.exp(b_last[:, :, None] - b)
    causal = jnp.tril(jnp.ones((CHUNK, CHUNK), dtype=bool))
    att = jnp.einsum('bnihd,bnjhd->bnhij', q_t, k_t)
    att = jnp.where(causal, att, 0.0)
    o_intra = jnp.einsum('bnhij,bnjhe->bnihe', att, vc)

    def step(state, xs):
        q_i, k_i, v_i, dec = xs
        o_i = jnp.einsum('bihd,bhde->bihe', q_i, state)
        new_state = dec[..., None] * state + jnp.einsum('bjhd,bjhe->bhde', k_i, v_i)
        return new_state, o_i

    s0 = jnp.zeros((bn, GLA_HEADS, GLA_DK, GLA_DV), f32)
    xs = (jnp.moveaxis(q_t, 1, 0), jnp.moveaxis(k_s, 1, 0), jnp.moveaxis(vc, 1, 0), jnp.moveaxis(jnp.exp(b_last), 1, 0))
    _, o_inter = lax.scan(step, s0, xs)
    o = (o_intra + jnp.moveaxis(o_inter, 0, 1)).reshape(bn, s, GLA_HEADS, GLA_DV)
    o = _rmsnorm(o, o_g).reshape(bn, s, GLA_HEADS * GLA_DV).astype(z.dtype)
    return o * jax.nn.silu(z)


def setup_inputs(seed: int = 0) -> dict:
    key = jax.random.key(seed)
    ks = jax.random.split(key, 24)
    f32 = jnp.float32
    nrm = lambda k, shp, sc: jax.random.normal(k, shp, f32) * sc
    gain = lambda k, shp: 1.0 + 0.02 * jax.random.normal(k, shp, f32)
    x = jax.random.normal(ks[0], (BATCH, SEQ, D_MODEL), f32)
    offset = jax.random.randint(ks[1], (BATCH, 1), 0, 4096, dtype=jnp.int32)
    positions = offset + jnp.arange(SEQ, dtype=jnp.int32)[None, :]
    return {
        'x': x,
        'positions': positions,
        'norm_g': gain(ks[2], (DEPTH, D_MODEL)),
        'w_in': nrm(ks[3], (DEPTH, D_MODEL, IN_COLS), D_MODEL ** -0.5),
        'b_gate': nrm(ks[4], (DEPTH, N_BRANCH * D_MODEL), 0.1),
        'sg_ln_g': gain(ks[5], (DEPTH, BRANCH_W)),
        'sg_ln_b': nrm(ks[6], (DEPTH, BRANCH_W), 0.02),
        'sg_w': nrm(ks[7], (DEPTH, SG_GROUPS, SG_BLOCK, SG_BLOCK), SG_BLOCK ** -0.5),
        'sg_b': gain(ks[8], (DEPTH, SG_GROUPS, SG_BLOCK)),
        'mla_cq_g': gain(ks[9], (DEPTH, MLA_Q_RANK)),
        'mla_ckv_g': gain(ks[10], (DEPTH, MLA_KV_RANK)),
        'mla_w_uq': nrm(ks[11], (DEPTH, MLA_Q_RANK, MLA_HEADS * MLA_QK), MLA_Q_RANK ** -0.5),
        'mla_w_ukv': nrm(ks[12], (DEPTH, MLA_KV_RANK, MLA_HEADS * (MLA_NOPE + MLA_V)), MLA_KV_RANK ** -0.5),
        'mla_q_g': gain(ks[13], (DEPTH, MLA_QK)),
        'mla_k_g': gain(ks[14], (DEPTH, MLA_QK)),
        'gla_w_gate': nrm(ks[15], (DEPTH, GLA_GATE_RANK, GLA_HEADS * GLA_DK), GLA_GATE_RANK ** -0.5),
        'gla_b_gate': nrm(ks[16], (DEPTH, GLA_HEADS * GLA_DK), 0.1),
        'gla_o_g': gain(ks[17], (DEPTH, GLA_DV)),
        'w_branch': nrm(ks[18], (DEPTH, N_BRANCH, BRANCH_W, D_MODEL), BRANCH_W ** -0.5),
        'w_out': nrm(ks[19], (DEPTH, D_MODEL, D_MODEL), D_MODEL ** -0.5),
    }


def reference(x, positions, norm_g, w_in, b_gate, sg_ln_g, sg_ln_b, sg_w, sg_b, mla_cq_g, mla_ckv_g,
              mla_w_uq, mla_w_ukv, mla_q_g, mla_k_g, gla_w_gate, gla_b_gate, gla_o_g, w_branch, w_out):
    bn, s, d = x.shape
    cos, sin = _rope_tables(positions)
    for l in range(DEPTH):
        h = _rmsnorm(x, norm_g[l])
        (u_a, v_a, z_a, c_q, c_kv, k_r, z_b, q_c, k_c, v_c, g_c, z_c, gate_logits) = _split_cols(h @ w_in[l])
        y_a = _spatial_gating(u_a, v_a, z_a, sg_ln_g[l], sg_ln_b[l], sg_w[l], sg_b[l])
        y_b = _mla(c_q, c_kv, k_r, z_b, mla_cq_g[l], mla_ckv_g[l], mla_w_uq[l], mla_w_ukv[l],
                   mla_q_g[l], mla_k_g[l], cos, sin)
        y_c = _gla(q_c, k_c, v_c, g_c, z_c, gla_w_gate[l], gla_b_gate[l], gla_o_g[l])
        gates = jax.nn.sigmoid(gate_logits + b_gate[l]).reshape(bn, s, N_BRANCH, d)
        merged = (gates[:, :, 0] * (y_a @ w_branch[l, 0])
                  + gates[:, :, 1] * (y_b @ w_branch[l, 1])
                  + gates[:, :, 2] * (y_c @ w_branch[l, 2]))
        x = x + merged @ w_out[l]
    return x
```

```cpp
#include <hip/hip_runtime.h>
#include <cstdio>
#include <cstdint>
#define FX_DEBUG 0
#define FX_DEBUG_SEL (-1)
#define FX_MULTI 0
#define FX_SLB 8
#define FX_DEBUG_TOL 0.03f
#define FX_TIME_PH 0
#define FX_ZEROWS 0
#define FX_HOLE 0
#define FX_SPLIT 0
#define FX_SYNCU 0
#define FX_PARTS 0
#define FX_CKSUM 0
#define FX_TWICE 0
#define FX_CKIDX (-1)
#define FX_CKN 64
#define FX_EXP 0
#define FX_CKDIV 1
#define FX_CKSUB 0
#define FX_SELFCHK 0
#define FX_NOPK __attribute__((target("no-packed-fp32-ops")))
#define FX_SELOFF 0

#define XB_TMO      128
#define XB_XCNT(j)  (256  + 64 * (j))
#define XB_XSUB(j)  (1280 + 64 * (j))
#define XB_XGEN(j)  (2304 + 64 * (j))
#define XB_TOP      3328
#define XB_TOPGEN   3392
#define XCD_BAR_WORDS 3456
#define XB_SPIN_CAP (1u << 18)
#define LAS __attribute__((address_space(3)))

__device__ __forceinline__ unsigned xb_ld(unsigned* p)              { return __hip_atomic_load(p, __ATOMIC_RELAXED, __HIP_MEMORY_SCOPE_AGENT); }
__device__ __forceinline__ unsigned xb_add(unsigned* p, unsigned v) { return __hip_atomic_fetch_add(p, v, __ATOMIC_RELAXED, __HIP_MEMORY_SCOPE_AGENT); }
__device__ __forceinline__ unsigned xb_xcc_id() { return (unsigned)__builtin_amdgcn_s_getreg((3 << 11) | 20) & 0xFu; }
#define XB_SPIN(cond, bar) do { unsigned _sp = 0; while (cond) { __builtin_amdgcn_s_sleep(1); \
    if ((++_sp & 255u) == 0u) { if (xb_ld(&(bar)[XB_TMO])) break; if (_sp > XB_SPIN_CAP) { atomicAdd(&(bar)[XB_TMO], 1u); break; } } } } while (0)

struct XcdBarrier {
    unsigned* bar; unsigned x;
    volatile LAS unsigned* st;
};

__device__ __forceinline__ XcdBarrier xcd_barrier_post(unsigned* bar, volatile LAS unsigned* st) {
    XcdBarrier b; b.bar = bar; b.x = xb_xcc_id(); b.st = st;
    if (threadIdx.x == 0) (void)xb_add(&bar[XB_XCNT(b.x)], 1u);
    return b;
}
__device__ __forceinline__ void xcd_barrier_complete(unsigned* bar, unsigned x, unsigned& nloc, unsigned& nx) {
    const unsigned G = gridDim.x * gridDim.y * gridDim.z;
    unsigned sum, cnt, mine, sp = 0u;
    for (;;) {
        sum = 0u; cnt = 0u; mine = 0u;
#pragma unroll
        for (unsigned j = 0; j < 16; ++j) { const unsigned c = xb_ld(&bar[XB_XCNT(j)]); sum += c; cnt += (c > 0u) ? 1u : 0u; mine = (j == x) ? c : mine; }
        if (sum == G) break;
        __builtin_amdgcn_s_sleep(1);
        if ((++sp & 255u) == 0u) { if (xb_ld(&bar[XB_TMO])) break; if (sp > XB_SPIN_CAP) { atomicAdd(&bar[XB_TMO], 1u); break; } }
    }
    nloc = mine > 0u ? mine : 1u; nx = cnt > 0u ? cnt : 1u;
}

__device__ __forceinline__ void xcd_barrier(const XcdBarrier& b) {
    asm volatile("s_waitcnt vmcnt(0)" ::: "memory");
    __syncthreads();
    if (threadIdx.x == 0) {
        unsigned* bar = b.bar;
        __builtin_amdgcn_s_waitcnt(0);
        unsigned nloc = b.st[0], nx = b.st[1];
        if (nloc == 0u) { xcd_barrier_complete(bar, b.x, nloc, nx); b.st[0] = nloc; b.st[1] = nx; }
        const unsigned old = xb_add(&bar[XB_XSUB(b.x)], 1u);
        const unsigned gen = old / nloc;
        if (old + 1u == (gen + 1u) * nloc) {
            __builtin_amdgcn_fence(__ATOMIC_RELEASE, "agent");
            asm volatile("s_waitcnt vmcnt(0)" ::: "memory");
            const unsigned og = xb_add(&bar[XB_TOP], 1u);
            const unsigned tg = og / nx;
            if (og + 1u == (tg + 1u) * nx) xb_add(&bar[XB_TOPGEN], 1u);
            else XB_SPIN(xb_ld(&bar[XB_TOPGEN]) == tg, bar);
            __builtin_amdgcn_fence(__ATOMIC_ACQUIRE, "agent");
            xb_add(&bar[XB_XGEN(b.x)], 1u);
            asm volatile("s_waitcnt vmcnt(0)" ::: "memory");
        } else {
            XB_SPIN(xb_ld(&bar[XB_XGEN(b.x)]) == gen, bar);
            __builtin_amdgcn_fence(__ATOMIC_ACQUIRE, "agent");
            asm volatile("s_waitcnt vmcnt(0)" ::: "memory");
        }
    }
    __syncthreads();
}

namespace pg8 {
#define PG8_LAS __attribute__((address_space(3)))
typedef unsigned short bf16_t;
typedef short bf16x8 __attribute__((ext_vector_type(8)));
typedef float f32x4 __attribute__((ext_vector_type(4)));
typedef unsigned u32x4 __attribute__((ext_vector_type(4)));
typedef unsigned u32x2 __attribute__((ext_vector_type(2)));
constexpr int BM = 256, BK = 64, HALF = 128, HTB = HALF * BK * 2  , STAGE_BYTES = 8 * HTB, NXCD = 8, WGM = 8;

__host__ __device__ __forceinline__ int lds_byte(int r, int c) { const int st = (r >> 4) * 2 + (c >> 5), rr = r & 15, cc = c & 31, ob = rr * 64 + cc * 2; return st * 1024 + (ob ^ (((ob >> 9) & 1) << 5)); }
__host__ __device__ __forceinline__ void stage_rc(int b, int& R, int& C) { const int st = b / 1024, sb = b % 1024, swz = sb ^ (((sb >> 9) & 1) << 5); R = (st >> 1) * 16 + swz / 64; C = (st & 1) * 32 + (swz % 64) / 2; }
__host__ __device__ __forceinline__ int perm32(int rho) { const int n = rho >> 4, i = rho & 15; return 8 * (i >> 2) + 4 * n + (i & 3); }

struct Unit { int pm, pn, br, keep; };
struct Gemm { const bf16_t* A; const bf16_t* Bt; int lda, ldb, K; long abr, bbr; int umask = -1; };

template <int CH> struct StaticOrderT {
    int nM, nN, nwg, G, c;
    __host__ __device__ void init(int M, int N, int G_, int c_) { nM = M / BM; nN = N / BM; nwg = nM * nN; G = G_; c = c_; }
    __host__ __device__ bool next(int i, Unit& u) const {
        const int r = i / CH, br = i % CH;
        const long L = (long)r * G + c; if (L >= nwg) return false;
        int wgid = (int)L; { const int q = nwg / NXCD, rr = nwg % NXCD, xcd = wgid % NXCD, off = wgid / NXCD; wgid = (xcd < rr ? xcd * (q + 1) : rr * (q + 1) + (xcd - rr) * q) + off; }
        const int nig = WGM * nN, gid = wgid / nig, fm = gid * WGM, gsz = (nM - fm) < WGM ? (nM - fm) : WGM;
        u.pm = fm + ((wgid % nig) % gsz); u.pn = (wgid % nig) / gsz; u.br = br; u.keep = (br < CH - 1) ? 1 : 0; return true;
    }
};
typedef StaticOrderT<1> StaticOrder;

__device__ __forceinline__ unsigned cvt_pk_bf16(float lo, float hi) { unsigned r; asm volatile("v_cvt_pk_bf16_f32 %0, %1, %2" : "=v"(r) : "v"(lo), "v"(hi)); return r; }

template <class Epi, class Sched, bool ALIGN_EPI = true, bool SP2 = true>
__device__ __forceinline__ void gemm_phase(PG8_LAS unsigned char* lds, const Gemm g, const Sched& S, const Epi& E) {
    int tid = threadIdx.x; asm volatile("" : "+v"(tid));
    const int wid = __builtin_amdgcn_readfirstlane(tid >> 6), lane = tid & 63, wr = wid >> 2, wc = wid & 3, fr = lane & 15, fq = lane >> 4;
    const int K = g.K, nt = K / BK;
    unsigned voffA[2], voffB[2];
#pragma unroll
    for (int i = 0; i < 2; ++i) { int R, C; stage_rc(tid * 16 + i * 8192, R, C); const int Rb = Epi::PERM ? ((R & ~31) + perm32(R & 31)) : R;
        voffA[i] = (unsigned)(R * g.lda + C) * 2u; voffB[i] = (unsigned)(Rb * g.ldb + C) * 2u; }
    const size_t kstep = (size_t)(BK * 2);
    const size_t hstepA = (size_t)HALF * g.lda * 2, hstepB = (size_t)HALF * g.ldb * 2;
    const size_t tstepA = 2 * hstepA, tstepB = 2 * hstepB;
    const unsigned ldsw = (unsigned)wid * 1024u;
    const int aoff = lds_byte(wr * 64 + fr, fq * 8), boff = lds_byte(wc * 32 + fr, fq * 8);
#define PG8_SA(b, h) (((b) * 2 + (h)) * HTB)
#define PG8_SB(b, h) ((4 + (b) * 2 + (h)) * HTB)
#define PG8_STAGE(bufoff, gbase, voff) do { _Pragma("unroll") for (int _i = 0; _i < 2; ++_i) \
        __builtin_amdgcn_global_load_lds((const unsigned*)((const char*)(gbase) + (voff)[_i]), (PG8_LAS unsigned*)(lds + (bufoff) + ldsw + _i * 8192), 16, 0, 0); } while (0)
#define PG8_LDA(dst, b, h) do { _Pragma("unroll") for (int m = 0; m < 4; ++m) _Pragma("unroll") for (int k = 0; k < 2; ++k) dst[m][k] = *(const PG8_LAS bf16x8*)(lds + PG8_SA(b, h) + aoff + m * 2048 + k * 1024); } while (0)
#define PG8_LDB(dst, b, h) do { _Pragma("unroll") for (int n = 0; n < 2; ++n) _Pragma("unroll") for (int k = 0; k < 2; ++k) dst[n][k] = *(const PG8_LAS bf16x8*)(lds + PG8_SB(b, h) + boff + n * 2048 + k * 1024); } while (0)
#define PG8_MMA(ai, bj, At, Bt) do { __builtin_amdgcn_s_setprio(1); _Pragma("unroll") for (int m = 0; m < 4; ++m) _Pragma("unroll") for (int n = 0; n < 2; ++n) _Pragma("unroll") for (int k = 0; k < 2; ++k) \
        acc[ai][bj][m][n] = __builtin_amdgcn_mfma_f32_16x16x32_bf16(Bt[n][k], At[m][k], acc[ai][bj][m][n], 0, 0, 0); __builtin_amdgcn_s_setprio(0); } while (0)
#define PG8_WAIT_V(n) asm volatile("s_waitcnt vmcnt(" #n ")" ::: "memory")
#define PG8_WAIT_L(n) asm volatile("s_waitcnt lgkmcnt(" #n ")" ::: "memory")
#define PG8_BAR __builtin_amdgcn_s_barrier()
#define PG8_SCHED __builtin_amdgcn_sched_barrier(0)
    Unit cur, nxt; int ui = 0;
    if (!S.next(0, cur)) return;
    f32x4 acc[2][2][4][2];
#pragma unroll
    for (int a = 0; a < 2; ++a)
#pragma unroll
        for (int b = 0; b < 2; ++b)
#pragma unroll
            for (int m = 0; m < 4; ++m)
#pragma unroll
                for (int n = 0; n < 2; ++n) acc[a][b][m][n] = (f32x4){0.f, 0.f, 0.f, 0.f};
    bf16x8 At[4][2], B0[2][2], B1[2][2];
    const char* cA = (const char*)g.A + (size_t)cur.br * g.abr + (size_t)(cur.pm & g.umask) * tstepA; const char* cB = (const char*)g.Bt + (size_t)cur.br * g.bbr + (size_t)(cur.pn & g.umask) * tstepB;
    if constexpr (SP2) {
        PG8_STAGE(PG8_SB(0, 0), cB, voffB); PG8_STAGE(PG8_SB(0, 1), cB + hstepB, voffB); PG8_STAGE(PG8_SA(0, 0), cA, voffA); PG8_STAGE(PG8_SA(0, 1), cA + hstepA, voffA);
        if (wr == 1) PG8_BAR;
        PG8_WAIT_V(2); PG8_BAR;
        PG8_STAGE(PG8_SB(1, 0), cB + kstep, voffB); PG8_STAGE(PG8_SA(1, 0), cA + kstep, voffA); PG8_STAGE(PG8_SB(1, 1), cB + hstepB + kstep, voffB);
        PG8_WAIT_V(6); PG8_BAR;
    } else {
        PG8_STAGE(PG8_SB(0, 0), cB, voffB); PG8_STAGE(PG8_SA(0, 0), cA, voffA); PG8_STAGE(PG8_SB(0, 1), cB + hstepB, voffB); PG8_STAGE(PG8_SA(0, 1), cA + hstepA, voffA);
        if (wr == 1) PG8_BAR;
        PG8_WAIT_V(4); PG8_BAR;
        PG8_STAGE(PG8_SB(1, 0), cB + kstep, voffB); PG8_STAGE(PG8_SA(1, 0), cA + kstep, voffA); PG8_STAGE(PG8_SB(1, 1), cB + hstepB + kstep, voffB);
        PG8_WAIT_V(6); PG8_BAR;
    }
    for (;;) {
        const bool has_next = S.next(ui + 1, nxt);
        const char* nA = has_next ? (const char*)g.A + (size_t)nxt.br * g.abr + (size_t)(nxt.pm & g.umask) * tstepA : cA; const char* nB = has_next ? (const char*)g.Bt + (size_t)nxt.br * g.bbr + (size_t)(nxt.pn & g.umask) * tstepB : cB;
        for (int t = 0; t < nt; t += 2) {
            const bool last = (t == nt - 2);
            const char* a1 = cA + (size_t)(t + 1) * kstep;
            const char* a2 = last ? nA : cA + (size_t)(t + 2) * kstep; const char* b2 = last ? nB : cB + (size_t)(t + 2) * kstep;
            const char* a3 = a2 + kstep; const char* b3 = b2 + kstep;
            if constexpr (SP2) {
            PG8_LDB(B0, 0, 0); PG8_LDB(B1, 0, 1); PG8_SCHED; PG8_LDA(At, 0, 0); PG8_STAGE(PG8_SA(1, 1), a1 + hstepA, voffA);
            PG8_WAIT_V(8); PG8_WAIT_L(0); PG8_BAR; PG8_MMA(0, 0, At, B0); PG8_MMA(0, 1, At, B1); PG8_BAR; PG8_SCHED;
            PG8_LDA(At, 0, 1); PG8_STAGE(PG8_SB(0, 0), b2, voffB); PG8_STAGE(PG8_SB(0, 1), b2 + hstepB, voffB); PG8_STAGE(PG8_SA(0, 0), a2, voffA);
            PG8_WAIT_V(8); PG8_WAIT_L(0); PG8_BAR; PG8_MMA(1, 0, At, B0); PG8_MMA(1, 1, At, B1); PG8_BAR; PG8_SCHED;
            PG8_LDB(B0, 1, 0); PG8_LDB(B1, 1, 1); PG8_SCHED; PG8_LDA(At, 1, 0); PG8_STAGE(PG8_SA(0, 1), a2 + hstepA, voffA);
            PG8_WAIT_V(8); PG8_WAIT_L(0); PG8_BAR; PG8_MMA(0, 0, At, B0); PG8_MMA(0, 1, At, B1); PG8_BAR; PG8_SCHED;
            PG8_LDA(At, 1, 1); PG8_STAGE(PG8_SB(1, 0), b3, voffB); PG8_STAGE(PG8_SB(1, 1), b3 + hstepB, voffB); PG8_STAGE(PG8_SA(1, 0), a3, voffA);
            PG8_WAIT_V(8); PG8_WAIT_L(0); PG8_BAR; PG8_MMA(1, 0, At, B0); PG8_MMA(1, 1, At, B1); PG8_BAR; PG8_SCHED;
            } else {
            PG8_LDB(B0, 0, 0); PG8_SCHED; PG8_LDA(At, 0, 0); PG8_STAGE(PG8_SA(1, 1), a1 + hstepA, voffA);
            PG8_WAIT_L(8); PG8_BAR; PG8_WAIT_L(0); PG8_MMA(0, 0, At, B0); PG8_BAR; PG8_SCHED;
            PG8_LDB(B1, 0, 1); PG8_STAGE(PG8_SB(0, 0), b2, voffB);
            PG8_BAR; PG8_WAIT_L(0); PG8_MMA(0, 1, At, B1); PG8_BAR;
            PG8_LDA(At, 0, 1); PG8_STAGE(PG8_SA(0, 0), a2, voffA);
            PG8_BAR; PG8_WAIT_L(0); PG8_MMA(1, 0, At, B0); PG8_BAR; PG8_SCHED;
            PG8_STAGE(PG8_SB(0, 1), b2 + hstepB, voffB);
            PG8_WAIT_V(6); PG8_BAR; PG8_MMA(1, 1, At, B1); PG8_BAR;
            PG8_LDB(B0, 1, 0); PG8_SCHED; PG8_LDA(At, 1, 0); PG8_STAGE(PG8_SA(0, 1), a2 + hstepA, voffA);
            PG8_WAIT_L(8); PG8_BAR; PG8_WAIT_L(0); PG8_MMA(0, 0, At, B0); PG8_BAR; PG8_SCHED;
            PG8_LDB(B1, 1, 1); PG8_STAGE(PG8_SB(1, 0), b3, voffB);
            PG8_BAR; PG8_WAIT_L(0); PG8_MMA(0, 1, At, B1); PG8_BAR;
            PG8_LDA(At, 1, 1); PG8_STAGE(PG8_SA(1, 0), a3, voffA);
            PG8_BAR; PG8_WAIT_L(0); PG8_MMA(1, 0, At, B0); PG8_BAR; PG8_SCHED;
            PG8_STAGE(PG8_SB(1, 1), b3 + hstepB, voffB);
            PG8_WAIT_V(6); PG8_BAR; PG8_MMA(1, 1, At, B1); PG8_BAR;
                    }
        }
        if constexpr (ALIGN_EPI) { if (wr == 0) PG8_BAR; }
        if constexpr (Epi::TWICE) E(acc, cur, wr, wc, fr, fq);
        E(acc, cur, wr, wc, fr, fq);
        if (!has_next) break;
        if (!cur.keep) {
#pragma unroll
            for (int a = 0; a < 2; ++a)
#pragma unroll
                for (int b = 0; b < 2; ++b)
#pragma unroll
                    for (int m = 0; m < 4; ++m)
#pragma unroll
                        for (int n = 0; n < 2; ++n) acc[a][b][m][n] = (f32x4){0.f, 0.f, 0.f, 0.f};
        }
        cur = nxt; cA = nA; cB = nB; ++ui;
        if constexpr (ALIGN_EPI) { if (wr == 1) PG8_BAR; }
    }
    PG8_WAIT_V(0);
    if constexpr (!ALIGN_EPI) { if (wr == 0) PG8_BAR; }
    PG8_BAR;
#undef PG8_SA
#undef PG8_SB
#undef PG8_STAGE
#undef PG8_LDA
#undef PG8_LDB
#undef PG8_MMA
#undef PG8_WAIT_V
#undef PG8_WAIT_L
#undef PG8_BAR
#undef PG8_SCHED
}
}

namespace fx {
using pg8::bf16_t; using pg8::bf16x8; using pg8::f32x4; using pg8::u32x4; using pg8::u32x2; using pg8::Unit;
typedef float f32x16 __attribute__((ext_vector_type(16)));
typedef short s16x4 __attribute__((ext_vector_type(4)));
typedef short v4i16_t __attribute__((ext_vector_type(4)));
typedef float f32x2 __attribute__((ext_vector_type(2)));
typedef LAS unsigned char* ldsp;

constexpr int D = 1024, NB = 16, S = 4096, DEPTH = 4, INC = 7088;
constexpr int SLB = FX_SLB, T = SLB * S, NSL = NB / SLB;
constexpr int NP = 7168, YW = 3584;
constexpr float EPS = 1e-6f;
constexpr int O_UA = 0, O_VA = 512, O_ZA = 1024, O_CQ = 1536, O_CKV = 1792, O_KR = 1920, O_ZB = 1952, O_QC = 2464, O_KC = 2720, O_VC = 2976, O_GC = 3488, O_ZC = 3504, O_GATE = 4016;
constexpr int Y_UZ = 0, Y_GV = 512, Y_CQ = 1024, Y_CKV = 1280, Y_KR = 1408, Y_GC = 1440, Y_ZB = 1536, Y_QC = 2048, Y_KC = 2304, Y_VC = 2560, Y_ZC = 3072;
constexpr int LDS_BYTES = 155648;
constexpr int LDS_BARW = LDS_BYTES - 16;
constexpr float QSCALE = 0.10206207261596577f * 1.4426950408889634f;

struct P {
    const float* x_in; const int* pos; const float* norm_g; const float* w_in; const float* b_gate; const float* sg_ln_g; const float* sg_ln_b; const float* sg_w; const float* sg_b;
    const float* cq_g; const float* ckv_g; const float* w_uq; const float* w_ukv; const float* q_g; const float* k_g; const float* w_gate; const float* bg_gate; const float* o_g;
    const float* w_branch; const float* w_out; float* out;
    unsigned* bar; bf16_t* xb; float* rstd; float* ssq; bf16_t* Y; bf16_t* Q; bf16_t* K; bf16_t* V; bf16_t* UT; bf16_t* ST; float* dec; bf16_t* merged; u32x2* GT;
    bf16_t* Win_t; bf16_t* Wuq_t; bf16_t* Wukv_t; bf16_t* Wbr_t; bf16_t* Wout_t; bf16_t* sgw; float* cs; float* sn;
};

__device__ __forceinline__ unsigned pk2(float lo, float hi) { typedef __bf16 b2 __attribute__((ext_vector_type(2))); f32x2 v = {lo, hi}; b2 b = __builtin_convertvector(v, b2); return __builtin_bit_cast(unsigned, b); }
__device__ __forceinline__ float bflo(unsigned w) { return __uint_as_float(w << 16); }
__device__ __forceinline__ float bfhi(unsigned w) { return __uint_as_float(w & 0xffff0000u); }
__device__ __forceinline__ float bf1(bf16_t b) { return __uint_as_float((unsigned)b << 16); }
__device__ __forceinline__ bf16_t f2bf(float f) { return (bf16_t)(pk2(f, 0.f) & 0xffffu); }
__device__ __forceinline__ float t_exp2(float x) { return __builtin_amdgcn_exp2f(x); }
__device__ __forceinline__ float t_log2(float x) { return __builtin_amdgcn_logf(x); }
__device__ __forceinline__ float t_rcp(float x) { return __builtin_amdgcn_rcpf(x); }
__device__ __forceinline__ float t_rsq(float x) { return __builtin_amdgcn_rsqf(x); }
__device__ __forceinline__ float fsig(float b) { return t_rcp(1.0f + t_exp2(-1.4426950408889634f * b)); }
__device__ __forceinline__ float fgelu_arg(float x) { return x * __builtin_fmaf(x * x, -1.4426950408889634f * 1.5957691216057308f * 0.044715f, -1.4426950408889634f * 1.5957691216057308f); }
__device__ __forceinline__ float fgelu(float x) { return x * t_rcp(1.0f + t_exp2(fgelu_arg(x))); }
__device__ __forceinline__ float fsilu(float x) { return x * fsig(x); }
__device__ __forceinline__ float fexp(float x) { return t_exp2(1.4426950408889634f * x); }
__device__ __forceinline__ float flogsig(float a) { return fminf(a, 0.f) - 0.6931471805599453f * t_log2(1.0f + t_exp2(-1.4426950408889634f * fabsf(a))); }
#define MFMA16(a, b, c) __builtin_amdgcn_mfma_f32_16x16x32_bf16(a, b, c, 0, 0, 0)
#define MFMA32(a, b, c) __builtin_amdgcn_mfma_f32_32x32x16_bf16(a, b, c, 0, 0, 0)

__host__ __device__ __forceinline__ int insrc(int np) {
    const int pn = np >> 8, x = np & 255;
    if (pn < 4) return (x < 128 ? O_UA : O_ZA) + 128 * pn + (x & 127);
    if (pn < 6) return O_VA + 256 * (pn - 4) + x;
    if (pn == 6) return O_CQ + x;
    if (pn == 7) return x < 128 ? O_CKV + x : x < 160 ? O_KR + (x - 128) : x < 176 ? O_GC + (x - 160) : -1;
    if (pn < 10) return O_ZB + 256 * (pn - 8) + x;
    if (pn == 10) return O_QC + x;
    if (pn == 11) return O_KC + x;
    if (pn < 14) return O_VC + 256 * (pn - 12) + x;
    if (pn < 16) return O_ZC + 256 * (pn - 14) + x;
    return O_GATE + 256 * (pn - 16) + x;
}

struct EpiIn {
    static constexpr bool PERM = true, TWICE = (FX_TIME_PH == 21);
    bf16_t* Y; const float* rstd; const float* bgate; u32x2* GT;
    __device__ __forceinline__ void operator()(f32x4 (&acc)[2][2][4][2], const Unit& u, int wr, int wc, int fr, int fq) const {
        const int row0 = u.pm * 256 + wr * 64 + fr, pn = u.pn;
        float rs[2][4];
#pragma unroll
        for (int ai = 0; ai < 2; ++ai)
#pragma unroll
            for (int m = 0; m < 4; ++m) rs[ai][m] = rstd[row0 + ai * 128 + m * 16];
        if (pn < 4) {
#pragma unroll
            for (int ai = 0; ai < 2; ++ai)
#pragma unroll
                for (int m = 0; m < 4; ++m) {
                    const float r = rs[ai][m]; float o[8];
#pragma unroll
                    for (int n = 0; n < 2; ++n)
#pragma unroll
                        for (int j = 0; j < 4; ++j) { const float uu = acc[ai][0][m][n][j] * r, zz = acc[ai][1][m][n][j] * r;
                            o[n * 4 + j] = uu * zz * t_rcp((1.0f + t_exp2(fgelu_arg(uu))) * (1.0f + t_exp2(-1.4426950408889634f * zz))); }
                    u32x4 w; w.x = pk2(o[0], o[1]); w.y = pk2(o[2], o[3]); w.z = pk2(o[4], o[5]); w.w = pk2(o[6], o[7]);
                    *(u32x4*)(Y + (size_t)(row0 + ai * 128 + m * 16) * YW + Y_UZ + 128 * pn + 32 * wc + 8 * fq) = w;
                }
        } else {
            const int type = (pn < 6) ? 1 : (pn < 8) ? 0 : (pn < 10) ? 2 : (pn < 14) ? 0 : (pn < 16) ? 2 : 3;
            const int colb = 256 * pn - 512 + 32 * wc + 8 * fq;
            if (type == 3) {
                f32x4 bl[2][2];
#pragma unroll
                for (int bj = 0; bj < 2; ++bj)
#pragma unroll
                    for (int n = 0; n < 2; ++n) bl[bj][n] = *(const f32x4*)(bgate + 256 * (pn - 16) + 128 * bj + 32 * wc + 8 * fq + 4 * n) * (-1.4426950408889634f);
#pragma unroll
                for (int ai = 0; ai < 2; ++ai)
#pragma unroll
                    for (int m = 0; m < 4; ++m) {
                        const float rl = rs[ai][m] * (-1.4426950408889634f);
#pragma unroll
                        for (int bj = 0; bj < 2; ++bj) {
                            u32x2 g8; g8.x = 0u; g8.y = 0u;
#pragma unroll
                            for (int j = 0; j < 4; ++j) {
                                const float g0 = t_rcp(__builtin_fmaf(t_exp2(__builtin_fmaf(acc[ai][bj][m][0][j], rl, bl[bj][0][j])), 1.0f / 255.0f, 1.0f / 255.0f));
                                const float g1 = t_rcp(__builtin_fmaf(t_exp2(__builtin_fmaf(acc[ai][bj][m][1][j], rl, bl[bj][1][j])), 1.0f / 255.0f, 1.0f / 255.0f));
                                g8.x = __builtin_amdgcn_cvt_pk_u8_f32(g0, j, g8.x); g8.y = __builtin_amdgcn_cvt_pk_u8_f32(g1, j, g8.y); }
                            GT[((size_t)(u.pm * 12 + (pn - 16)) * 16 + (ai * 4 + m) * 2 + bj) * 512 + (wr * 4 + wc) * 64 + fq * 16 + fr] = g8;
                        }
                    }
            } else {
#pragma unroll
            for (int ai = 0; ai < 2; ++ai)
#pragma unroll
                for (int m = 0; m < 4; ++m) {
                    const float r = rs[ai][m];
#pragma unroll
                    for (int bj = 0; bj < 2; ++bj) {
                        float o[8];
#pragma unroll
                        for (int n = 0; n < 2; ++n)
#pragma unroll
                            for (int j = 0; j < 4; ++j) { const float v = acc[ai][bj][m][n][j] * r; o[n * 4 + j] = (type == 0) ? v : (type == 1) ? fgelu(v) : fsilu(v); }
                        u32x4 w; w.x = pk2(o[0], o[1]); w.y = pk2(o[2], o[3]); w.z = pk2(o[4], o[5]); w.w = pk2(o[6], o[7]);
                        *(u32x4*)(Y + (size_t)(row0 + ai * 128 + m * 16) * YW + colb + 128 * bj) = w;
                    }
                }
            }
        }
    }
};
struct EpiMerge {
    static constexpr bool PERM = true, TWICE = false;
    const u32x2* GT; bf16_t* merged;
    __device__ __forceinline__ void operator()(f32x4 (&acc)[2][2][4][2], const Unit& u, int wr, int wc, int fr, int fq) const {
        const int row0 = u.pm * 256 + wr * 64 + fr, br = u.br;
        const u32x2* gp = GT + ((size_t)(u.pm * 12 + br * 4 + u.pn) * 16) * 512 + (wr * 4 + wc) * 64; const int lo = (fq * 16 + fr) * 8;
        const __amdgpu_buffer_rsrc_t gr = __builtin_amdgcn_make_buffer_rsrc((void*)gp, 0, 1 << 20, 0x00020000);
#pragma unroll
        for (int ai = 0; ai < 2; ++ai) {
            u32x2 ga[8];
#pragma unroll
            for (int s8 = 0; s8 < 8; ++s8) ga[s8] = __builtin_bit_cast(u32x2, __builtin_amdgcn_raw_buffer_load_b64(gr, lo, (ai * 8 + s8) * 4096, 0));
            if (br < 2) {
                u32x2 gb[8];
#pragma unroll
                for (int s8 = 0; s8 < 8; ++s8) gb[s8] = __builtin_bit_cast(u32x2, __builtin_amdgcn_raw_buffer_load_b64(gr, lo, (64 + ai * 8 + s8) * 4096, 0));
                __builtin_amdgcn_sched_barrier(0);
#pragma unroll
                for (int m = 0; m < 4; ++m)
#pragma unroll
                    for (int bj = 0; bj < 2; ++bj) {
                        const u32x2 a = ga[m * 2 + bj], bq = gb[m * 2 + bj];
                        float f[8], h[8];
#pragma unroll
                        for (int j = 0; j < 4; ++j) { f[j] = (float)((a.x >> (8 * j)) & 255u); f[4 + j] = (float)((a.y >> (8 * j)) & 255u); h[j] = (float)((bq.x >> (8 * j)) & 255u); h[4 + j] = (float)((bq.y >> (8 * j)) & 255u); }
#pragma unroll
                        for (int j = 0; j < 8; ++j) f[j] = fmaxf(f[j], 255e-18f) * t_rcp(fmaxf(h[j], 255e-18f));
#pragma unroll
                        for (int n = 0; n < 2; ++n)
#pragma unroll
                            for (int j = 0; j < 4; ++j) acc[ai][bj][m][n][j] *= f[n * 4 + j];
                    }
            } else {
                __builtin_amdgcn_sched_barrier(0);
#pragma unroll
                for (int m = 0; m < 4; ++m) {
                    const int row = row0 + ai * 128 + m * 16;
#pragma unroll
                    for (int bj = 0; bj < 2; ++bj) {
                        const int col = u.pn * 256 + 128 * bj + 32 * wc + 8 * fq;
                        const u32x2 a = ga[m * 2 + bj];
                        float f[8], o[8];
#pragma unroll
                        for (int j = 0; j < 4; ++j) { f[j] = (float)((a.x >> (8 * j)) & 255u); f[4 + j] = (float)((a.y >> (8 * j)) & 255u); }
#pragma unroll
                        for (int n = 0; n < 2; ++n)
#pragma unroll
                            for (int j = 0; j < 4; ++j) o[n * 4 + j] = acc[ai][bj][m][n][j] * fmaxf(f[n * 4 + j] * (1.0f / 255.0f), 1e-18f);
                        u32x4 w; w.x = pk2(o[0], o[1]); w.y = pk2(o[2], o[3]); w.z = pk2(o[4], o[5]); w.w = pk2(o[6], o[7]);
                        *(u32x4*)(merged + (size_t)row * D + col) = w;
                    }
                }
            }
        }
    }
};
struct EpiOut {
    static constexpr bool PERM = true, TWICE = false;
    const float* xin; float* out; const bf16_t* xb; bf16_t* xbw; float* ssq; int first, last;
    template <bool FIRST, bool LAST, int MB> __device__ __forceinline__ void run(f32x4 (&acc)[2][2][4][2], const Unit& u, int wr, int wc, int fr, int fq) const {
        const int lo = fr * D + 8 * fq;
        const size_t ub = (size_t)(u.pm * 256 + wr * 64) * D + u.pn * 256 + 32 * wc;
#pragma unroll
        for (int ai = 0; ai < 2; ++ai)
#pragma unroll
            for (int m0 = 0; m0 < 4; m0 += MB) {
                f32x4 xa[MB][2][2]; u32x4 xw[MB][2];
#pragma unroll
                for (int mm = 0; mm < MB; ++mm)
#pragma unroll
                    for (int bj = 0; bj < 2; ++bj) {
                        const size_t o = ub + (size_t)(ai * 128 + (m0 + mm) * 16) * D + 128 * bj;
                        if (FIRST) { xa[mm][bj][0] = *(const f32x4*)(xin + o + lo); xa[mm][bj][1] = *(const f32x4*)(xin + o + lo + 4); }
                        else xw[mm][bj] = *(const u32x4*)(xb + o + lo);
                    }
                __builtin_amdgcn_sched_barrier(0);
#pragma unroll
                for (int mm = 0; mm < MB; ++mm) {
                    const int m = m0 + mm; float ss = 0.f;
#pragma unroll
                    for (int bj = 0; bj < 2; ++bj) {
                        const size_t o = ub + (size_t)(ai * 128 + m * 16) * D + 128 * bj;
                        float xr[8];
                        if (FIRST) { const f32x4 a = xa[mm][bj][0], b = xa[mm][bj][1]; xr[0] = a[0]; xr[1] = a[1]; xr[2] = a[2]; xr[3] = a[3]; xr[4] = b[0]; xr[5] = b[1]; xr[6] = b[2]; xr[7] = b[3]; }
                        else { const u32x4 w4 = xw[mm][bj]; xr[0] = bflo(w4.x); xr[1] = bfhi(w4.x); xr[2] = bflo(w4.y); xr[3] = bfhi(w4.y); xr[4] = bflo(w4.z); xr[5] = bfhi(w4.z); xr[6] = bflo(w4.w); xr[7] = bfhi(w4.w); }
                        float v[8];
#pragma unroll
                        for (int n = 0; n < 2; ++n)
#pragma unroll
                            for (int j = 0; j < 4; ++j) v[n * 4 + j] = xr[n * 4 + j] + acc[ai][bj][m][n][j];
                        if (LAST) { f32x4 va, vb; va[0] = v[0]; va[1] = v[1]; va[2] = v[2]; va[3] = v[3]; vb[0] = v[4]; vb[1] = v[5]; vb[2] = v[6]; vb[3] = v[7]; *(f32x4*)(out + o + lo) = va; *(f32x4*)(out + o + lo + 4) = vb; }
                        else {
#pragma unroll
                            for (int j = 0; j < 8; ++j) ss += v[j] * v[j];
                            u32x4 w; w.x = pk2(v[0], v[1]); w.y = pk2(v[2], v[3]); w.z = pk2(v[4], v[5]); w.w = pk2(v[6], v[7]); *(u32x4*)(xbw + o + lo) = w; }
                    }
                    if (!LAST) { ss += __shfl_xor(ss, 16); ss += __shfl_xor(ss, 32); if (fq == 0) ssq[((size_t)(u.pm * 256 + wr * 64 + fr + ai * 128 + m * 16) * 4 + u.pn) * 32 + wc] = ss; }
                }
            }
    }
    __device__ __forceinline__ void operator()(f32x4 (&acc)[2][2][4][2], const Unit& u, int wr, int wc, int fr, int fq) const {
        if (first) run<true, false, 2>(acc, u, wr, wc, fr, fq);
        else if (last) run<false, true, 4>(acc, u, wr, wc, fr, fq);
        else run<false, false, 4>(acc, u, wr, wc, fr, fq);
    }
};

template <int MODE> __device__ __forceinline__ void conv_wt(const float* src, int ldn, int K, bf16_t* dst, int Np, const float* gk, ldsp lds, int tid) {
    const int tn = Np >> 6, tk = K >> 6, ntile = tn * tk;
    LAS bf16_t* Tt = (LAS bf16_t*)lds;
    const int kr = tid >> 3, c8 = (tid & 7) * 8;
    f32x4 v0, v1; float gsc;
#define CW_LOAD(tile_) do { const int n0_ = ((tile_) % tn) * 64, k0_ = ((tile_) / tn) * 64; const int col_ = (MODE == 0) ? insrc(n0_ + c8) : n0_ + c8; \
        v0 = (f32x4){0.f, 0.f, 0.f, 0.f}; v1 = v0; \
        if (col_ >= 0) { const float* sp_ = src + (size_t)(k0_ + kr) * ldn + col_; v0 = *(const f32x4*)sp_; v1 = *(const f32x4*)(sp_ + 4); } \
        gsc = gk ? gk[k0_ + kr] : 1.0f; } while (0)
    int tile = blockIdx.x;
    if (tile < ntile) CW_LOAD(tile);
    for (; tile < ntile; tile += gridDim.x) {
        const int n0 = (tile % tn) * 64, k0 = (tile / tn) * 64;
#pragma unroll
        for (int j = 0; j < 4; ++j) { Tt[(c8 + j) * 72 + kr] = f2bf(v0[j] * gsc); Tt[(c8 + 4 + j) * 72 + kr] = f2bf(v1[j] * gsc); }
        __syncthreads();
        if (tile + (int)gridDim.x < ntile) CW_LOAD(tile + (int)gridDim.x);
        { const int n = tid >> 3, kc = (tid & 7) * 8; *(u32x4*)(dst + (size_t)(n0 + n) * K + k0 + kc) = *(const LAS u32x4*)(Tt + n * 72 + kc); }
        __syncthreads();
    }
#undef CW_LOAD
}
__device__ __forceinline__ void p0_prologue(const P& p, ldsp lds) {
    int tid = threadIdx.x; asm volatile("" : "+v"(tid));
    const int gtid = blockIdx.x * 512 + tid, gth = gridDim.x * 512;
    for (int l = 0; l < DEPTH; ++l) {
        conv_wt<0>(p.w_in + (size_t)l * D * INC, INC, D, p.Win_t + (size_t)l * NP * D, NP, p.norm_g + l * D, lds, tid);
        conv_wt<1>(p.w_uq + (size_t)l * 256 * 768, 768, 256, p.Wuq_t + (size_t)l * 768 * 256, 768, p.cq_g + l * 256, lds, tid);
        conv_wt<1>(p.w_ukv + (size_t)l * 128 * 1024, 1024, 128, p.Wukv_t + (size_t)l * 1024 * 128, 1024, p.ckv_g + l * 128, lds, tid);
        for (int i = 0; i < 3; ++i) conv_wt<1>(p.w_branch + ((size_t)l * 3 + i) * 512 * D, D, 512, p.Wbr_t + ((size_t)l * 3 + i) * D * 512, D, nullptr, lds, tid);
        conv_wt<1>(p.w_out + (size_t)l * D * D, D, D, p.Wout_t + (size_t)l * D * D, D, nullptr, lds, tid);
    }
    for (int i = gtid; i < DEPTH * 4 * 128 * 128; i += gth) { const int j = i & 127, ii = (i >> 7) & 127; p.sgw[i] = ((ii >> 6) >= (j >> 6)) ? f2bf(p.sg_w[i]) : (bf16_t)0; }
    for (int i = gtid; i < NB * S * 16; i += gth) { const int t = i >> 4, f = i & 15; const double inv = exp(-(double)f * (2.0 / 32.0) * log(10000.0)); const double ang = (double)p.pos[t] * inv; p.cs[i] = (float)cos(ang); p.sn[i] = (float)sin(ang); }
    const int lane = tid & 63, gw = gtid >> 6, nw = gth >> 6;
    for (int row0 = gw * 4; row0 < NB * S; row0 += nw * 4) {
        f32x4 v[4][4];
#pragma unroll
        for (int r = 0; r < 4; ++r)
#pragma unroll
            for (int j = 0; j < 4; ++j) v[r][j] = *(const f32x4*)(p.x_in + (size_t)(row0 + r) * D + j * 256 + lane * 4);
        __builtin_amdgcn_sched_barrier(0);
#pragma unroll
        for (int r = 0; r < 4; ++r) { float ss = 0.f;
#pragma unroll
            for (int j = 0; j < 4; ++j) { ss += (v[r][j][0] * v[r][j][0] + v[r][j][1] * v[r][j][1]) + (v[r][j][2] * v[r][j][2] + v[r][j][3] * v[r][j][3]);
                u32x2 w; w.x = pk2(v[r][j][0], v[r][j][1]); w.y = pk2(v[r][j][2], v[r][j][3]); *(u32x2*)(p.xb + (size_t)(row0 + r) * D + j * 256 + lane * 4) = w; }
#pragma unroll
            for (int o = 32; o > 0; o >>= 1) ss += __shfl_xor(ss, o);
            if (lane == 0) p.rstd[row0 + r] = t_rsq(ss * (1.0f / D) + EPS); }
    }
}
__device__ __forceinline__ void p8_rstd(const P& p, int ps) {
    int tid = threadIdx.x; asm volatile("" : "+v"(tid));
    for (int row = ps * T + blockIdx.x * 512 + tid; row < (ps + 1) * T; row += gridDim.x * 512) {
        f32x4 a[4];
#pragma unroll
        for (int t4 = 0; t4 < 4; ++t4) a[t4] = *(const f32x4*)(p.ssq + ((size_t)row * 4 + t4) * 32);
        __builtin_amdgcn_sched_barrier(0);
        float s = 0.f;
#pragma unroll
        for (int t4 = 0; t4 < 4; ++t4) s += (a[t4][0] + a[t4][1]) + (a[t4][2] + a[t4][3]);
        p.rstd[row] = t_rsq(s * (1.0f / D) + EPS);
    }
}

constexpr int ML_STR = 424;
constexpr int ML_T1 = 64 * ML_STR * 2, ML_CS = 2 * ML_T1, ML_QG = ML_CS + 2 * 8192, ML_KG = ML_QG + 384, ML_R1 = ML_KG + 384, ML_END = ML_R1 + 512;
static_assert(ML_END <= LDS_BARW, "MLA LDS map");
__device__ __forceinline__ void mla_units(const P& p, int l, int sl, int ubeg, int ustep, int uend, ldsp lds) {
    int tid = threadIdx.x; asm volatile("" : "+v"(tid) :: "memory");
    const int h = __builtin_amdgcn_readfirstlane(tid >> 6);
    if (ubeg >= uend) return;
    if (tid < 24) *(LAS f32x4*)(lds + ML_QG + tid * 16) = *(const f32x4*)(p.q_g + l * 96 + 4 * tid);
    else if (tid >= 32 && tid < 56) *(LAS f32x4*)(lds + ML_KG + (tid - 32) * 16) = *(const f32x4*)(p.k_g + l * 96 + 4 * (tid - 32));
#define MLA_DMA(un_, bb_) do { \
        const bf16_t* ys_ = p.Y + (size_t)(un_) * 64 * YW + Y_CQ; \
        int ln_ = threadIdx.x & 63; asm volatile("" : "+v"(ln_));         \
        for (int j_ = h; j_ < 53; j_ += 8) { const int pc_ = j_ * 64 + ln_, r_ = pc_ / 53, c_ = min(pc_ % 53, 51); \
            __builtin_amdgcn_global_load_lds((const unsigned*)(ys_ + (size_t)r_ * YW + c_ * 8), (LAS unsigned*)(lds + (bb_) * ML_T1 + j_ * 1024), 16, 0, 0); } \
        const float* rt_ = ((h & 4) ? p.sn : p.cs) + ((size_t)sl * T + (size_t)(un_) * 64) * 16 + (h & 3) * 256 + ln_ * 4; \
        __builtin_amdgcn_global_load_lds((const unsigned*)rt_, (LAS unsigned*)(lds + ML_CS + (bb_) * 8192 + (h >> 2) * 4096 + (h & 3) * 1024), 16, 0, 0); \
    } while (0)
    MLA_DMA(ubeg, 0);
    int bsel = 0;
    if (h < 4) __builtin_amdgcn_s_setprio(2);
  for (int un = ubeg; un < uend; un += ustep, bsel ^= 1) {
    asm volatile("s_waitcnt vmcnt(0)" ::: "memory");
    __syncthreads();
    int t2 = threadIdx.x; asm volatile("" : "+v"(t2) :: "memory");
    const int lane = t2 & 63, fr = lane & 15, g = lane >> 4;
    const bool has_next = un + ustep < uend;
    const ldsp tl = lds + bsel * ML_T1, cl = lds + ML_CS + bsel * 8192;
    {
        const int tk_ = lane >> 3 | ((int)(threadIdx.x >> 6) << 3), part = lane & 7; float sq_ = 0.f, sk_ = 0.f;
        bf16x8 xq[4], xk[2];
#pragma unroll
        for (int i = 0; i < 4; ++i) xq[i] = *(const LAS bf16x8*)(tl + (tk_ * ML_STR + part * 32 + 8 * i) * 2);
#pragma unroll
        for (int i = 0; i < 2; ++i) xk[i] = *(const LAS bf16x8*)(tl + (tk_ * ML_STR + 256 + part * 16 + 8 * i) * 2);
#pragma unroll
        for (int i = 0; i < 4; ++i)
#pragma unroll
            for (int j = 0; j < 8; ++j) { const float v = bf1((bf16_t)xq[i][j]); sq_ += v * v; }
#pragma unroll
        for (int i = 0; i < 2; ++i)
#pragma unroll
            for (int j = 0; j < 8; ++j) { const float v = bf1((bf16_t)xk[i][j]); sk_ += v * v; }
        sq_ += __shfl_xor(sq_, 1); sq_ += __shfl_xor(sq_, 2); sq_ += __shfl_xor(sq_, 4);
        sk_ += __shfl_xor(sk_, 1); sk_ += __shfl_xor(sk_, 2); sk_ += __shfl_xor(sk_, 4);
        if (part == 0) { ((LAS float*)(lds + ML_R1))[tk_] = t_rsq(sq_ * (1.0f / 256.0f) + EPS); ((LAS float*)(lds + ML_R1))[64 + tk_] = t_rsq(sk_ * (1.0f / 128.0f) + EPS); }
    }
    __syncthreads();
    const int r0 = un * 64;
    const int bl = r0 / S, s0 = r0 % S;
    bf16_t* Qo = p.Q + ((size_t)(bl * 8 + h) * S + s0) * 96; bf16_t* Ko = p.K + ((size_t)(bl * 8 + h) * S + s0) * 96; bf16_t* Vo = p.V + ((size_t)(bl * 8 + h) * S + s0) * 64;
    const ldsp xb_ = tl + (fr * ML_STR + 8 * g) * 2;
    {
        const bf16_t* W = p.Wuq_t + ((size_t)l * 768 + h * 96) * 256 + (size_t)fr * 256 + 8 * g;
        f32x4 acc[6][4];
#pragma unroll
        for (int a = 0; a < 6; ++a)
#pragma unroll
            for (int b = 0; b < 4; ++b) acc[a][b] = (f32x4){0.f, 0.f, 0.f, 0.f};
#pragma unroll
        for (int ps = 0; ps < 3; ++ps) {
            asm volatile("" ::: "memory");
            bf16x8 wf[8][2];
#pragma unroll
            for (int ks = 0; ks < 8; ++ks)
#pragma unroll
                for (int m2 = 0; m2 < 2; ++m2) wf[ks][m2] = *(const bf16x8*)(W + (size_t)(16 * (2 * ps + m2)) * 256 + 32 * ks);
            bf16x8 xf[2][4];
#pragma unroll
            for (int nt = 0; nt < 4; ++nt) xf[0][nt] = *(const LAS bf16x8*)(xb_ + (16 * nt * ML_STR) * 2);
#pragma unroll
            for (int ks = 0; ks < 8; ++ks) {
                if (ks + 1 < 8) {
#pragma unroll
                    for (int nt = 0; nt < 4; ++nt) xf[(ks + 1) & 1][nt] = *(const LAS bf16x8*)(xb_ + (16 * nt * ML_STR + 32 * (ks + 1)) * 2);
                }
                __builtin_amdgcn_sched_barrier(0);
#pragma unroll
                for (int m2 = 0; m2 < 2; ++m2)
#pragma unroll
                    for (int nt = 0; nt < 4; ++nt) acc[2 * ps + m2][nt] = MFMA16(wf[ks][m2], xf[ks & 1][nt], acc[2 * ps + m2][nt]);
                __builtin_amdgcn_sched_barrier(0);
            }
        }
        asm volatile("" ::: "memory");
        float qg[6][4];
#pragma unroll
        for (int mt = 0; mt < 6; ++mt) { const f32x4 t4 = *(const LAS f32x4*)(lds + ML_QG + (16 * mt + 4 * g) * 4); qg[mt][0] = t4[0]; qg[mt][1] = t4[1]; qg[mt][2] = t4[2]; qg[mt][3] = t4[3]; }
        f32x4 c4[4], s4[4];
#pragma unroll
        for (int nt = 0; nt < 4; ++nt) { c4[nt] = *(const LAS f32x4*)(cl + ((16 * nt + fr) * 16 + 4 * g) * 4); s4[nt] = *(const LAS f32x4*)(cl + 4096 + ((16 * nt + fr) * 16 + 4 * g) * 4); }
#pragma unroll
        for (int nt = 0; nt < 4; ++nt) {
            const float r1 = ((const LAS float*)(lds + ML_R1))[16 * nt + fr];
            float sq = 0.f;
#pragma unroll
            for (int mt = 0; mt < 6; ++mt) { acc[mt][nt] = acc[mt][nt] * r1; sq += (acc[mt][nt][0] * acc[mt][nt][0] + acc[mt][nt][1] * acc[mt][nt][1]) + (acc[mt][nt][2] * acc[mt][nt][2] + acc[mt][nt][3] * acc[mt][nt][3]); }
            sq += __shfl_xor(sq, 16); sq += __shfl_xor(sq, 32);
            const float rq = t_rsq(sq * (1.0f / 96.0f) + EPS) * QSCALE;
            const int tk = 16 * nt + fr;
            bf16_t* qo = Qo + (size_t)tk * 96 + 4 * g;
#pragma unroll
            for (int mt = 0; mt < 4; ++mt) { u32x2 w; w.x = pk2(acc[mt][nt][0] * rq * qg[mt][0], acc[mt][nt][1] * rq * qg[mt][1]); w.y = pk2(acc[mt][nt][2] * rq * qg[mt][2], acc[mt][nt][3] * rq * qg[mt][3]); *(u32x2*)(qo + 16 * mt) = w; }
            float o1[4], o2[4];
#pragma unroll
            for (int j = 0; j < 4; ++j) { const float x1 = acc[4][nt][j] * rq * qg[4][j], x2 = acc[5][nt][j] * rq * qg[5][j]; o1[j] = x1 * c4[nt][j] - x2 * s4[nt][j]; o2[j] = x1 * s4[nt][j] + x2 * c4[nt][j]; }
            u32x2 w1, w2; w1.x = pk2(o1[0], o1[1]); w1.y = pk2(o1[2], o1[3]); w2.x = pk2(o2[0], o2[1]); w2.y = pk2(o2[2], o2[3]);
            *(u32x2*)(qo + 64) = w1; *(u32x2*)(qo + 80) = w2;
        }
    }
    {
        const bf16_t* W = p.Wukv_t + ((size_t)l * 1024 + h * 128) * 128 + (size_t)fr * 128 + 8 * g;
        float r1[4];
#pragma unroll
        for (int nt = 0; nt < 4; ++nt) r1[nt] = ((const LAS float*)(lds + ML_R1))[64 + 16 * nt + fr];
        f32x4 c4[4], s4[4];
#pragma unroll
        for (int nt = 0; nt < 4; ++nt) { c4[nt] = *(const LAS f32x4*)(cl + ((16 * nt + fr) * 16 + 4 * g) * 4); s4[nt] = *(const LAS f32x4*)(cl + 4096 + ((16 * nt + fr) * 16 + 4 * g) * 4); }
#pragma unroll
        for (int ps = 0; ps < 2; ++ps) {
            asm volatile("" ::: "memory");
            f32x4 acc[4][4];
#pragma unroll
            for (int a = 0; a < 4; ++a)
#pragma unroll
                for (int b = 0; b < 4; ++b) acc[a][b] = (f32x4){0.f, 0.f, 0.f, 0.f};
            bf16x8 wf[4][4];
#pragma unroll
            for (int ks = 0; ks < 4; ++ks)
#pragma unroll
                for (int m4 = 0; m4 < 4; ++m4) wf[ks][m4] = *(const bf16x8*)(W + (size_t)(16 * (4 * ps + m4)) * 128 + 32 * ks);
            bf16x8 xf[2][4];
#pragma unroll
            for (int nt = 0; nt < 4; ++nt) xf[0][nt] = *(const LAS bf16x8*)(xb_ + (16 * nt * ML_STR + 256) * 2);
#pragma unroll
            for (int ks = 0; ks < 4; ++ks) {
                if (ks + 1 < 4) {
#pragma unroll
                    for (int nt = 0; nt < 4; ++nt) xf[(ks + 1) & 1][nt] = *(const LAS bf16x8*)(xb_ + (16 * nt * ML_STR + 256 + 32 * (ks + 1)) * 2);
                }
                __builtin_amdgcn_sched_barrier(0);
#pragma unroll
                for (int m4 = 0; m4 < 4; ++m4)
#pragma unroll
                    for (int nt = 0; nt < 4; ++nt) acc[m4][nt] = MFMA16(wf[ks][m4], xf[ks & 1][nt], acc[m4][nt]);
                __builtin_amdgcn_sched_barrier(0);
            }
            if (ps == 0) {
                if (has_next) MLA_DMA(un + ustep, bsel ^ 1);
                float kg[6][4];
#pragma unroll
                for (int mt = 0; mt < 6; ++mt) { const f32x4 t4 = *(const LAS f32x4*)(lds + ML_KG + (16 * mt + 4 * g) * 4); kg[mt][0] = t4[0]; kg[mt][1] = t4[1]; kg[mt][2] = t4[2]; kg[mt][3] = t4[3]; }
#pragma unroll
                for (int nt = 0; nt < 4; ++nt) {
                    const int tk = 16 * nt + fr;
                    u32x2 ka, kb;
                    ka = *(const LAS u32x2*)(tl + (tk * ML_STR + 384 + 4 * g) * 2); kb = *(const LAS u32x2*)(tl + (tk * ML_STR + 400 + 4 * g) * 2);
                    float k1[4] = {bflo(ka.x), bfhi(ka.x), bflo(ka.y), bfhi(ka.y)}, k2[4] = {bflo(kb.x), bfhi(kb.x), bflo(kb.y), bfhi(kb.y)};
                    float sk = 0.f;
#pragma unroll
                    for (int mt = 0; mt < 4; ++mt) { acc[mt][nt] = acc[mt][nt] * r1[nt]; sk += (acc[mt][nt][0] * acc[mt][nt][0] + acc[mt][nt][1] * acc[mt][nt][1]) + (acc[mt][nt][2] * acc[mt][nt][2] + acc[mt][nt][3] * acc[mt][nt][3]); }
#pragma unroll
                    for (int j = 0; j < 4; ++j) sk += k1[j] * k1[j] + k2[j] * k2[j];
                    sk += __shfl_xor(sk, 16); sk += __shfl_xor(sk, 32);
                    const float rk = t_rsq(sk * (1.0f / 96.0f) + EPS);
                    bf16_t* ko = Ko + (size_t)tk * 96 + 4 * g;
#pragma unroll
                    for (int mt = 0; mt < 4; ++mt) { u32x2 w; w.x = pk2(acc[mt][nt][0] * rk * kg[mt][0], acc[mt][nt][1] * rk * kg[mt][1]); w.y = pk2(acc[mt][nt][2] * rk * kg[mt][2], acc[mt][nt][3] * rk * kg[mt][3]); *(u32x2*)(ko + 16 * mt) = w; }
                    float o1[4], o2[4];
#pragma unroll
                    for (int j = 0; j < 4; ++j) { const float x1 = k1[j] * rk * kg[4][j], x2 = k2[j] * rk * kg[5][j]; o1[j] = x1 * c4[nt][j] - x2 * s4[nt][j]; o2[j] = x1 * s4[nt][j] + x2 * c4[nt][j]; }
                    u32x2 w1, w2; w1.x = pk2(o1[0], o1[1]); w1.y = pk2(o1[2], o1[3]); w2.x = pk2(o2[0], o2[1]); w2.y = pk2(o2[2], o2[3]);
                    *(u32x2*)(ko + 64) = w1; *(u32x2*)(ko + 80) = w2;
                }
            } else {
#pragma unroll
                for (int nt = 0; nt < 4; ++nt) { bf16_t* vo = Vo + (size_t)(16 * nt + fr) * 64 + 4 * g;
#pragma unroll
                    for (int mt = 0; mt < 4; ++mt) { const f32x4 v = acc[mt][nt] * r1[nt]; u32x2 w; w.x = pk2(v[0], v[1]); w.y = pk2(v[2], v[3]); *(u32x2*)(vo + 16 * mt) = w; } }
            }
        }
    }
  }
#undef MLA_DMA
    __builtin_amdgcn_s_setprio(0);
    __syncthreads();
}

constexpr int M2_A = 0, M2_B = 51200, M2_G = 51200 + 35840, M2_END = M2_G + 768;
constexpr int M2_AROW = 528, M2_ASEG = 16 * 528 + 64, M2_BROW = 272, M2_BSEG = 16 * 272 + 64;
static_assert(M2_END <= LDS_BARW, "MLA (128-token form) LDS map");
__device__ __forceinline__ void mla_units128(const P& p, int l, int sl, int ubeg, int ustep, int uend, ldsp lds) {
    int tid = threadIdx.x; asm volatile("" : "+v"(tid) :: "memory");
    const int lane = tid & 63, fr = lane & 15, g = lane >> 4; const int w = __builtin_amdgcn_readfirstlane(tid >> 6);
    const bf16_t* Wq = p.Wuq_t + (size_t)l * 768 * 256; const bf16_t* Wkv = p.Wukv_t + (size_t)l * 1024 * 128;
#define M2_DMA_A(h_) do { const bf16_t* src_ = Wq + (size_t)(h_) * 96 * 256; int ln_ = threadIdx.x & 63; asm volatile("" : "+v"(ln_));     \
        for (int i_ = 0; i_ < 7; ++i_) { const int j_ = min(w + 8 * i_, 49); const int pc_ = j_ * 64 + ln_; const int sg_ = pc_ / 532, q_ = min(pc_ % 532, 527); const int row_ = min(sg_ * 16 + q_ / 33, 95), c_ = min(q_ % 33, 31); \
            __builtin_amdgcn_global_load_lds((const unsigned*)(src_ + row_ * 256 + c_ * 8), (LAS unsigned*)(lds + M2_A + j_ * 1024), 16, 0, 0); } } while (0)
#define M2_DMA_B(h_) do { const bf16_t* src_ = Wkv + (size_t)(h_) * 128 * 128; int ln_ = threadIdx.x & 63; asm volatile("" : "+v"(ln_)); \
        for (int i_ = 0; i_ < 5; ++i_) { const int j_ = min(w + 8 * i_, 34); const int pc_ = j_ * 64 + ln_; const int sg_ = pc_ / 276, q_ = min(pc_ % 276, 271); const int row_ = min(sg_ * 16 + q_ / 17, 127), c_ = min(q_ % 17, 15); \
            __builtin_amdgcn_global_load_lds((const unsigned*)(src_ + row_ * 128 + c_ * 8), (LAS unsigned*)(lds + M2_B + j_ * 1024), 16, 0, 0); } } while (0)
#define M2_BAR() asm volatile("s_waitcnt lgkmcnt(0)\n\ts_barrier" ::: "memory")
    for (int un = ubeg; un < uend; un += ustep) {
        const int r0 = un * 128, bl = r0 / S, s0 = r0 % S, tk = 16 * w + fr;
        const size_t tokg = (size_t)sl * T + r0;
        M2_DMA_A(0); M2_DMA_B(0);
        const int pl = 8 * (fr >> 2) + (fr & 3);
        const int oa0 = (pl >> 4) * M2_ASEG + (pl & 15) * M2_AROW + g * 16, oa1 = ((pl + 4) >> 4) * M2_ASEG + ((pl + 4) & 15) * M2_AROW + g * 16, oar = fr * M2_AROW + g * 16;
        const int ob0 = (pl >> 4) * M2_BSEG + (pl & 15) * M2_BROW + g * 16, ob1 = ((pl + 4) >> 4) * M2_BSEG + ((pl + 4) & 15) * M2_BROW + g * 16;
        const bf16_t* yr = p.Y + (size_t)(r0 + tk) * YW;
        bf16x8 xq[8], xkv[4];
#pragma unroll
        for (int ks = 0; ks < 8; ++ks) xq[ks] = *(const bf16x8*)(yr + Y_CQ + 32 * ks + 8 * g);
#pragma unroll
        for (int ks = 0; ks < 4; ++ks) xkv[ks] = *(const bf16x8*)(yr + Y_CKV + 32 * ks + 8 * g);
        const u32x2 kra = *(const u32x2*)(yr + Y_KR + 4 * g), krb = *(const u32x2*)(yr + Y_KR + 16 + 4 * g);
        const f32x4 c4 = *(const f32x4*)(p.cs + (tokg + tk) * 16 + 4 * g), s4 = *(const f32x4*)(p.sn + (tokg + tk) * 16 + 4 * g);
        if (tid < 24) *(LAS f32x4*)(lds + M2_G + tid * 16) = *(const f32x4*)(p.q_g + l * 96 + 4 * tid);
        else if (tid >= 32 && tid < 56) *(LAS f32x4*)(lds + M2_G + 384 + (tid - 32) * 16) = *(const f32x4*)(p.k_g + l * 96 + 4 * (tid - 32));
        float sq_ = 0.f, sk_ = 0.f;
#pragma unroll
        for (int ks = 0; ks < 8; ++ks)
#pragma unroll
            for (int j = 0; j < 8; ++j) { const float v = bf1((bf16_t)xq[ks][j]); sq_ += v * v; }
#pragma unroll
        for (int ks = 0; ks < 4; ++ks)
#pragma unroll
            for (int j = 0; j < 8; ++j) { const float v = bf1((bf16_t)xkv[ks][j]); sk_ += v * v; }
        sq_ += __shfl_xor(sq_, 16); sq_ += __shfl_xor(sq_, 32); sk_ += __shfl_xor(sk_, 16); sk_ += __shfl_xor(sk_, 32);
        const float r1q = t_rsq(sq_ * (1.0f / 256.0f) + EPS), r1k = t_rsq(sk_ * (1.0f / 128.0f) + EPS);
        const float k1[4] = {bflo(kra.x), bfhi(kra.x), bflo(kra.y), bfhi(kra.y)}, k2[4] = {bflo(krb.x), bfhi(krb.x), bflo(krb.y), bfhi(krb.y)};
        asm volatile("s_waitcnt vmcnt(0)" ::: "memory");
        M2_BAR();
        for (int h = 0; h < 8; ++h) {
            bf16_t* qo = p.Q + ((size_t)(bl * 8 + h) * S + s0 + tk) * 96 + 4 * g; bf16_t* ko = p.K + ((size_t)(bl * 8 + h) * S + s0 + tk) * 96 + 4 * g;
            bf16_t* qo8 = qo + 4 * g; bf16_t* ko8 = ko + 4 * g; bf16_t* vo8 = p.V + ((size_t)(bl * 8 + h) * S + s0 + tk) * 64 + 8 * g;
            if (h > 0) { asm volatile("s_waitcnt vmcnt(9)" ::: "memory"); M2_BAR(); }
            f32x4 acc[6];
#pragma unroll
            for (int mt = 0; mt < 6; ++mt) acc[mt] = (f32x4){0.f, 0.f, 0.f, 0.f};
#pragma unroll
            for (int ks = 0; ks < 8; ++ks) {
                bf16x8 a[6];
#pragma unroll
                for (int mt = 0; mt < 6; ++mt) a[mt] = *(const LAS bf16x8*)(lds + M2_A + (mt < 4 ? 2 * (mt >> 1) * M2_ASEG + ((mt & 1) ? oa1 : oa0) : mt * M2_ASEG + oar) + ks * 64);
#pragma unroll
                for (int mt = 0; mt < 6; ++mt) acc[mt] = MFMA16(a[mt], xq[ks], acc[mt]);
            }
            __builtin_amdgcn_sched_barrier(0);
            f32x4 ac2[8];
#pragma unroll
            for (int m = 0; m < 8; ++m) ac2[m] = (f32x4){0.f, 0.f, 0.f, 0.f};
#pragma unroll
            for (int ks = 0; ks < 4; ++ks) {
                bf16x8 b[8];
#pragma unroll
                for (int m = 0; m < 8; ++m) b[m] = *(const LAS bf16x8*)(lds + M2_B + 2 * (m >> 1) * M2_BSEG + ((m & 1) ? ob1 : ob0) + ks * 64);
#pragma unroll
                for (int m = 0; m < 8; ++m) ac2[m] = MFMA16(b[m], xkv[ks], ac2[m]);
            }
            __builtin_amdgcn_sched_barrier(0);
            M2_BAR();
            if (h < 7) { M2_DMA_A(h + 1); M2_DMA_B(h + 1); }
            {
                f32x4 qg[6];
#pragma unroll
                for (int mt = 0; mt < 6; ++mt) qg[mt] = *(const LAS f32x4*)(lds + M2_G + (mt < 4 ? 32 * (mt >> 1) + 8 * g + 4 * (mt & 1) : 16 * mt + 4 * g) * 4);
                float sqn = 0.f;
#pragma unroll
                for (int mt = 0; mt < 6; ++mt) sqn += (acc[mt][0] * acc[mt][0] + acc[mt][1] * acc[mt][1]) + (acc[mt][2] * acc[mt][2] + acc[mt][3] * acc[mt][3]);
                sqn += __shfl_xor(sqn, 16); sqn += __shfl_xor(sqn, 32);
                const float rq = t_rsq(sqn * (r1q * r1q * (1.0f / 96.0f)) + EPS) * (r1q * QSCALE);
#pragma unroll
                for (int a2 = 0; a2 < 2; ++a2) { u32x4 o;
                    o.x = pk2(acc[2 * a2][0] * rq * qg[2 * a2][0], acc[2 * a2][1] * rq * qg[2 * a2][1]); o.y = pk2(acc[2 * a2][2] * rq * qg[2 * a2][2], acc[2 * a2][3] * rq * qg[2 * a2][3]);
                    o.z = pk2(acc[2 * a2 + 1][0] * rq * qg[2 * a2 + 1][0], acc[2 * a2 + 1][1] * rq * qg[2 * a2 + 1][1]); o.w = pk2(acc[2 * a2 + 1][2] * rq * qg[2 * a2 + 1][2], acc[2 * a2 + 1][3] * rq * qg[2 * a2 + 1][3]);
                    *(u32x4*)(qo8 + 32 * a2) = o; }
                float o1[4], o2[4];
#pragma unroll
                for (int j = 0; j < 4; ++j) { const float x1 = acc[4][j] * rq * qg[4][j], x2 = acc[5][j] * rq * qg[5][j]; o1[j] = x1 * c4[j] - x2 * s4[j]; o2[j] = x1 * s4[j] + x2 * c4[j]; }
                u32x2 w1, w2; w1.x = pk2(o1[0], o1[1]); w1.y = pk2(o1[2], o1[3]); w2.x = pk2(o2[0], o2[1]); w2.y = pk2(o2[2], o2[3]);
                *(u32x2*)(qo + 64) = w1; *(u32x2*)(qo + 80) = w2;
            }
            {
                f32x4 kg[6];
#pragma unroll
                for (int mt = 0; mt < 6; ++mt) kg[mt] = *(const LAS f32x4*)(lds + M2_G + 384 + (mt < 4 ? 32 * (mt >> 1) + 8 * g + 4 * (mt & 1) : 16 * mt + 4 * g) * 4);
                float skn = 0.f;
#pragma unroll
                for (int mt = 0; mt < 4; ++mt) skn += (ac2[mt][0] * ac2[mt][0] + ac2[mt][1] * ac2[mt][1]) + (ac2[mt][2] * ac2[mt][2] + ac2[mt][3] * ac2[mt][3]);
                skn *= r1k * r1k;
#pragma unroll
                for (int j = 0; j < 4; ++j) skn += k1[j] * k1[j] + k2[j] * k2[j];
                skn += __shfl_xor(skn, 16); skn += __shfl_xor(skn, 32);
                const float rk = t_rsq(skn * (1.0f / 96.0f) + EPS), rkn = rk * r1k;
#pragma unroll
                for (int a2 = 0; a2 < 2; ++a2) { u32x4 o;
                    o.x = pk2(ac2[2 * a2][0] * rkn * kg[2 * a2][0], ac2[2 * a2][1] * rkn * kg[2 * a2][1]); o.y = pk2(ac2[2 * a2][2] * rkn * kg[2 * a2][2], ac2[2 * a2][3] * rkn * kg[2 * a2][3]);
                    o.z = pk2(ac2[2 * a2 + 1][0] * rkn * kg[2 * a2 + 1][0], ac2[2 * a2 + 1][1] * rkn * kg[2 * a2 + 1][1]); o.w = pk2(ac2[2 * a2 + 1][2] * rkn * kg[2 * a2 + 1][2], ac2[2 * a2 + 1][3] * rkn * kg[2 * a2 + 1][3]);
                    *(u32x4*)(ko8 + 32 * a2) = o; }
                float o1[4], o2[4];
#pragma unroll
                for (int j = 0; j < 4; ++j) { const float x1 = k1[j] * rk * kg[4][j], x2 = k2[j] * rk * kg[5][j]; o1[j] = x1 * c4[j] - x2 * s4[j]; o2[j] = x1 * s4[j] + x2 * c4[j]; }
                u32x2 w1, w2; w1.x = pk2(o1[0], o1[1]); w1.y = pk2(o1[2], o1[3]); w2.x = pk2(o2[0], o2[1]); w2.y = pk2(o2[2], o2[3]);
                *(u32x2*)(ko + 64) = w1; *(u32x2*)(ko + 80) = w2;
#pragma unroll
                for (int a2 = 0; a2 < 2; ++a2) { const f32x4 v0 = ac2[4 + 2 * a2] * r1k, v1 = ac2[5 + 2 * a2] * r1k; u32x4 o; o.x = pk2(v0[0], v0[1]); o.y = pk2(v0[2], v0[3]); o.z = pk2(v1[0], v1[1]); o.w = pk2(v1[2], v1[3]); *(u32x4*)(vo8 + 32 * a2) = o; }
            }
        }
        asm volatile("s_waitcnt vmcnt(0)" ::: "memory");
        M2_BAR();
    }
#undef M2_DMA_A
#undef M2_DMA_B
#undef M2_BAR
}

constexpr int GL_BC = 0, GL_VT = 0, GL_QT = 73728, GL_KT = 107520, GL_G = 141312, GL_END = 145408;
static_assert(GL_END <= LDS_BARW, "GLA LDS map");
__device__ __forceinline__ void gla_cumsum(const P& p, int l, int r0, ldsp lds, int tid) {
    LAS float* gsm = (LAS float*)(lds + GL_G); LAS float* Bc = (LAS float*)(lds + GL_BC);
    { const int t = tid >> 3, r2 = (tid & 7) * 2; const unsigned w = *(const unsigned*)(p.Y + (size_t)(r0 + t) * YW + Y_GC + r2); gsm[t * 16 + r2] = bflo(w); gsm[t * 16 + r2 + 1] = bfhi(w); }
    const int hd = tid & 255, half = tid >> 8;
    float w[16];
#pragma unroll
    for (int r = 0; r < 16; ++r) w[r] = p.w_gate[((size_t)l * 16 + r) * 256 + hd];
    const float bias = p.bg_gate[l * 256 + hd];
    __syncthreads();
    float run = 0.f;
    LAS float* bcp = Bc + (32 * half) * 256 + hd; const LAS f32x4* g4 = (const LAS f32x4*)(gsm + (32 * half) * 16);
#pragma unroll 2
    for (int i0 = 0; i0 < 32; i0 += 4) {
        f32x4 gv[4][4];
#pragma unroll
        for (int ii = 0; ii < 4; ++ii)
#pragma unroll
            for (int q = 0; q < 4; ++q) gv[ii][q] = g4[(i0 + ii) * 4 + q];
        __builtin_amdgcn_sched_barrier(0);
        float rv[4];
#pragma unroll
        for (int ii = 0; ii < 4; ++ii) {
            float a = bias;
#pragma unroll
            for (int q = 0; q < 4; ++q) a += gv[ii][q][0] * w[4 * q] + gv[ii][q][1] * w[4 * q + 1] + gv[ii][q][2] * w[4 * q + 2] + gv[ii][q][3] * w[4 * q + 3];
            run += flogsig(a) * (1.0f / 16.0f); rv[ii] = run;
        }
#pragma unroll
        for (int ii = 0; ii < 4; ++ii) bcp[(i0 + ii) * 256] = rv[ii];
    }
    __syncthreads();
    if (half == 1) { const float add = Bc[31 * 256 + hd];
#pragma unroll 4
        for (int i = 0; i < 32; ++i) bcp[i * 256] += add; }
    __syncthreads();
}
__device__ __forceinline__ void gla_load_vt(const P& p, int r0, ldsp lds, int tid) {
    const int he = tid; LAS unsigned* VT = (LAS unsigned*)(lds + GL_VT);
    const bf16_t* src = p.Y + (size_t)r0 * YW + Y_VC + he;
#pragma unroll
    for (int tb = 0; tb < 64; tb += 32) {
        unsigned v[32];
#pragma unroll
        for (int t = 0; t < 32; ++t) v[t] = src[(size_t)(tb + t) * YW];
        __builtin_amdgcn_sched_barrier(0);
#pragma unroll
        for (int t = 0; t < 32; t += 2) VT[(he * 72 + tb + t) >> 1] = v[t] | (v[t + 1] << 16);
        __builtin_amdgcn_sched_barrier(0);
    }
}
__device__ __forceinline__ void gla_a_unit(const P& p, int l, int un, ldsp lds) {
    int tid = threadIdx.x; asm volatile("" : "+v"(tid) :: "memory");
    const int lane = tid & 63, fr = lane & 15, g = lane >> 4; const int w = __builtin_amdgcn_readfirstlane(tid >> 6);
    const int r0 = un * 64, bl = r0 / S, n = (r0 % S) >> 6;
    gla_cumsum(p, l, r0, lds, tid);
    LAS float* Bc = (LAS float*)(lds + GL_BC); LAS unsigned* KsT = (LAS unsigned*)(lds + GL_QT);
    { const int hd = tid & 255, half = tid >> 8; const float bl_ = Bc[63 * 256 + hd];
      const bf16_t* src = p.Y + (size_t)r0 * YW + Y_KC + hd;
      const bf16_t* srch = src + (size_t)(32 * half) * YW; LAS float* bch = Bc + (32 * half) * 256 + hd; LAS unsigned* ksh = KsT + ((hd * 72 + 32 * half) >> 1);
      unsigned kv[32];
#pragma unroll
      for (int i = 0; i < 32; ++i) kv[i] = srch[(size_t)i * YW];
#pragma unroll
      for (int i = 0; i < 32; i += 2) {
          const float k0 = bf1((bf16_t)kv[i]) * fexp(bl_ - bch[i * 256]), k1 = bf1((bf16_t)kv[i + 1]) * fexp(bl_ - bch[(i + 1) * 256]);
          ksh[i >> 1] = pk2(k0, k1); }
      if (half == 0) p.dec[((size_t)(bl * 4 + (hd >> 6)) * 64 + n) * 64 + (hd & 63)] = fexp(bl_); }
    __syncthreads();
    gla_load_vt(p, r0, lds, tid);
    __syncthreads();
    const int h = w >> 1, eh = w & 1;
    f32x4 acc[4][4];
#pragma unroll
    for (int a = 0; a < 4; ++a)
#pragma unroll
        for (int b = 0; b < 4; ++b) acc[a][b] = (f32x4){0.f, 0.f, 0.f, 0.f};
#pragma unroll
    for (int ks = 0; ks < 2; ++ks) {
        bf16x8 af[4], bf[4];
#pragma unroll
        for (int md = 0; md < 4; ++md) af[md] = *(const LAS bf16x8*)(lds + GL_QT + ((h * 64 + 16 * md + fr) * 72 + 32 * ks + 8 * g) * 2);
#pragma unroll
        for (int ne = 0; ne < 4; ++ne) bf[ne] = *(const LAS bf16x8*)(lds + GL_VT + ((h * 128 + 64 * eh + 16 * ne + fr) * 72 + 32 * ks + 8 * g) * 2);
#pragma unroll
        for (int md = 0; md < 4; ++md)
#pragma unroll
            for (int ne = 0; ne < 4; ++ne) acc[md][ne] = MFMA16(af[md], bf[ne], acc[md][ne]);
    }
    bf16_t* U = p.UT + ((size_t)(bl * 4 + h) * 64 + n) * 8192;
#pragma unroll
    for (int md = 0; md < 4; ++md)
#pragma unroll
        for (int ne = 0; ne < 4; ++ne) { u32x2 o; o.x = pk2(acc[md][ne][0], acc[md][ne][1]); o.y = pk2(acc[md][ne][2], acc[md][ne][3]); *(u32x2*)(U + (size_t)(64 * eh + 16 * ne + fr) * 64 + 16 * md + 4 * g) = o; }
    __syncthreads();
}
__device__ __forceinline__ void gla_scan(const P& p) {
    int tid = threadIdx.x; asm volatile("" : "+v"(tid));
    const size_t i0 = (size_t)blockIdx.x * 1024 + tid * 2;
    for (size_t i = i0; i < (size_t)SLB * 4 * 8192; i += (size_t)gridDim.x * 1024) {
        const size_t bh4 = i >> 13, ed = i & 8191; const int d = (int)(ed & 63);
        float s0 = 0.f, s1 = 0.f;
#pragma unroll 8
        for (int n = 0; n < 64; ++n) {
            const size_t o = (bh4 * 64 + n) * 8192 + ed;
            const unsigned u = *(const unsigned*)(p.UT + o); const f32x2 dc = *(const f32x2*)(p.dec + (bh4 * 64 + n) * 64 + d);
            *(unsigned*)(p.ST + o) = pk2(s0, s1);
            s0 = dc[0] * s0 + bflo(u); s1 = dc[1] * s1 + bfhi(u);
        }
    }
}
__device__ __forceinline__ void gla_b_unit(const P& p, int l, int un, ldsp lds, bool DRY) {
    int tid = threadIdx.x; asm volatile("" : "+v"(tid) :: "memory");
    const int lane = tid & 63, fr = lane & 15, g = lane >> 4; const int w = __builtin_amdgcn_readfirstlane(tid >> 6);
    const int r0 = un * 64, bl = r0 / S, n = (r0 % S) >> 6;
    gla_cumsum(p, l, r0, lds, tid);
    LAS float* Bc = (LAS float*)(lds + GL_BC);
    {
        const int t = tid >> 3, c = tid & 7; LAS bf16_t* QT = (LAS bf16_t*)(lds + GL_QT); LAS bf16_t* KT = (LAS bf16_t*)(lds + GL_KT);
        const bf16_t* qs = p.Y + (size_t)(r0 + t) * YW + Y_QC + 8 * c; const bf16_t* ks = p.Y + (size_t)(r0 + t) * YW + Y_KC + 8 * c;
        u32x4 qv[4], kv[4];
#pragma unroll
        for (int j = 0; j < 4; ++j) { qv[j] = *(const u32x4*)(qs + 64 * j); kv[j] = *(const u32x4*)(ks + 64 * j); }
        __builtin_amdgcn_sched_barrier(0);
#pragma unroll
        for (int j = 0; j < 4; ++j) {
            const LAS f32x4* bp = (const LAS f32x4*)(Bc + t * 256 + 64 * j + 8 * c); const f32x4 b0 = bp[0], b1 = bp[1];
            const float bb[8] = {b0[0], b0[1], b0[2], b0[3], b1[0], b1[1], b1[2], b1[3]};
            const unsigned qw[4] = {qv[j].x, qv[j].y, qv[j].z, qv[j].w}, kw[4] = {kv[j].x, kv[j].y, kv[j].z, kv[j].w};
            unsigned qo[4], ko[4];
#pragma unroll
            for (int e2 = 0; e2 < 4; ++e2) {
                qo[e2] = pk2(bflo(qw[e2]) * 0.125f * fexp(bb[2 * e2]), bfhi(qw[e2]) * 0.125f * fexp(bb[2 * e2 + 1]));
                ko[e2] = pk2(bflo(kw[e2]) * fexp(-bb[2 * e2]), bfhi(kw[e2]) * fexp(-bb[2 * e2 + 1])); }
            *(LAS u32x4*)(QT + t * 264 + 64 * j + 8 * c) = (u32x4){qo[0], qo[1], qo[2], qo[3]};
            *(LAS u32x4*)(KT + t * 264 + 64 * j + 8 * c) = (u32x4){ko[0], ko[1], ko[2], ko[3]};
        }
    }
    __syncthreads();
    gla_load_vt(p, r0, lds, tid);
    const int h = w >> 1, eh = w & 1;
    f32x4 at[4][2];
#pragma unroll
    for (int a = 0; a < 4; ++a)
#pragma unroll
        for (int b = 0; b < 2; ++b) at[a][b] = (f32x4){0.f, 0.f, 0.f, 0.f};
#pragma unroll
    for (int ks = 0; ks < 2; ++ks) {
        bf16x8 af[4], bf[2];
#pragma unroll
        for (int mj = 0; mj < 4; ++mj) af[mj] = *(const LAS bf16x8*)(lds + GL_KT + ((16 * mj + fr) * 264 + h * 64 + 32 * ks + 8 * g) * 2);
#pragma unroll
        for (int ni = 0; ni < 2; ++ni) bf[ni] = *(const LAS bf16x8*)(lds + GL_QT + ((32 * eh + 16 * ni + fr) * 264 + h * 64 + 32 * ks + 8 * g) * 2);
#pragma unroll
        for (int mj = 0; mj < 4; ++mj)
#pragma unroll
            for (int ni = 0; ni < 2; ++ni) at[mj][ni] = MFMA16(af[mj], bf[ni], at[mj][ni]);
    }
    f32x4 acc[4][4];
#pragma unroll
    for (int a = 0; a < 4; ++a)
#pragma unroll
        for (int b = 0; b < 4; ++b) acc[a][b] = (f32x4){0.f, 0.f, 0.f, 0.f};
    const bf16_t* Sg = p.ST + ((size_t)(bl * 4 + h) * 64 + n) * 8192;
#pragma unroll
    for (int ks = 0; ks < 2; ++ks) {
        bf16x8 af[4], bf[4];
#pragma unroll
        for (int me = 0; me < 4; ++me) af[me] = *(const bf16x8*)(Sg + (size_t)(64 * eh + 16 * me + fr) * 64 + 32 * ks + 8 * g);
#pragma unroll
        for (int ni = 0; ni < 4; ++ni) bf[ni] = *(const LAS bf16x8*)(lds + GL_QT + ((16 * ni + fr) * 264 + h * 64 + 32 * ks + 8 * g) * 2);
#pragma unroll
        for (int me = 0; me < 4; ++me)
#pragma unroll
            for (int ni = 0; ni < 4; ++ni) acc[me][ni] = MFMA16(af[me], bf[ni], acc[me][ni]);
    }
    __syncthreads();
    {
        LAS unsigned char* AT = lds + GL_QT + h * 9216;
#pragma unroll
        for (int mj = 0; mj < 4; ++mj)
#pragma unroll
            for (int ni = 0; ni < 2; ++ni) { const int i = 32 * eh + 16 * ni + fr, j0 = 16 * mj + 4 * g;
                float v[4];
#pragma unroll
                for (int r = 0; r < 4; ++r) v[r] = (j0 + r <= i) ? at[mj][ni][r] : 0.f;
                u32x2 o; o.x = pk2(v[0], v[1]); o.y = pk2(v[2], v[3]); *(LAS u32x2*)(AT + (i * 72 + j0) * 2) = o; }
    }
    __syncthreads();
#pragma unroll
    for (int ks = 0; ks < 2; ++ks) {
        bf16x8 af[4], bf[4];
#pragma unroll
        for (int me = 0; me < 4; ++me) af[me] = *(const LAS bf16x8*)(lds + GL_VT + ((h * 128 + 64 * eh + 16 * me + fr) * 72 + 32 * ks + 8 * g) * 2);
#pragma unroll
        for (int ni = 0; ni < 4; ++ni) bf[ni] = *(const LAS bf16x8*)(lds + GL_QT + h * 9216 + ((16 * ni + fr) * 72 + 32 * ks + 8 * g) * 2);
#pragma unroll
        for (int me = 0; me < 4; ++me)
#pragma unroll
            for (int ni = 0; ni < 4; ++ni) acc[me][ni] = MFMA16(af[me], bf[ni], acc[me][ni]);
    }
    u32x2 zc[4][4];
#pragma unroll
    for (int ni = 0; ni < 4; ++ni)
#pragma unroll
        for (int me = 0; me < 4; ++me) zc[ni][me] = *(const u32x2*)(p.Y + (size_t)(r0 + 16 * ni + fr) * YW + Y_ZC + h * 128 + 64 * eh + 4 * g + 16 * me);
    __builtin_amdgcn_sched_barrier(0);
    LAS float* red = (LAS float*)(lds + GL_G);
#pragma unroll
    for (int ni = 0; ni < 4; ++ni) { float ss = 0.f;
#pragma unroll
        for (int me = 0; me < 4; ++me) ss += (acc[me][ni][0] * acc[me][ni][0] + acc[me][ni][1] * acc[me][ni][1]) + (acc[me][ni][2] * acc[me][ni][2] + acc[me][ni][3] * acc[me][ni][3]);
        ss += __shfl_xor(ss, 16); ss += __shfl_xor(ss, 32);
        if (g == 0) red[w * 64 + 16 * ni + fr] = ss; }
    __syncthreads();
    float og[4][4];
#pragma unroll
    for (int me = 0; me < 4; ++me) { const f32x4 t4 = *(const f32x4*)(p.o_g + l * 128 + 64 * eh + 16 * me + 4 * g); og[me][0] = t4[0]; og[me][1] = t4[1]; og[me][2] = t4[2]; og[me][3] = t4[3]; }
#pragma unroll
    for (int ni = 0; ni < 4; ++ni) { const int i = 16 * ni + fr;
        const float rr = t_rsq((red[w * 64 + i] + red[(w ^ 1) * 64 + i]) * (1.0f / 128.0f) + EPS);
        bf16_t* yo = p.Y + (size_t)(r0 + i) * YW + Y_ZC + h * 128 + 64 * eh + 4 * g;
        bf16_t* yw = DRY ? p.merged + (size_t)(r0 + i) * D + 512 + h * 128 + 64 * eh + 4 * g : yo;
#pragma unroll
        for (int me = 0; me < 4; ++me) { const u32x2 z = zc[ni][me];
            u32x2 o; o.x = pk2(acc[me][ni][0] * rr * og[me][0] * bflo(z.x), acc[me][ni][1] * rr * og[me][1] * bfhi(z.x)); o.y = pk2(acc[me][ni][2] * rr * og[me][2] * bflo(z.y), acc[me][ni][3] * rr * og[me][3] * bfhi(z.y));
            *(u32x2*)(yw + 16 * me) = o; } }
    __syncthreads();
}

constexpr int SG_STR = 136;
constexpr int SG_LN = 512 * SG_STR * 2;
static_assert(SG_LN + 4096 <= LDS_BARW, "SG LDS map");
__device__ __forceinline__ void sg_unit(const P& p, int l, int un, ldsp lds, bool DRY) {
    int tid = threadIdx.x; asm volatile("" : "+v"(tid) :: "memory");
    const int lane = tid & 63, fr = lane & 15, g = lane >> 4; const int w = __builtin_amdgcn_readfirstlane(tid >> 6);
    const int r0 = un * 128;
    {
        const int j = tid >> 2, qd = tid & 3; LAS bf16_t* VnT = (LAS bf16_t*)lds;
        const bf16_t* src = p.Y + (size_t)(r0 + j) * YW + Y_GV + 128 * qd;
        if (tid < 128) *(LAS f32x4*)(lds + SG_LN + tid * 16) = *(const f32x4*)(p.sg_ln_g + l * 512 + 4 * tid);
        else if (tid < 256) *(LAS f32x4*)(lds + SG_LN + 2048 + (tid - 128) * 16) = *(const f32x4*)(p.sg_ln_b + l * 512 + 4 * (tid - 128));
        u32x4 x[16]; float s = 0.f;
#pragma unroll
        for (int i = 0; i < 16; ++i) { x[i] = *(const u32x4*)(src + 8 * i); s += (bflo(x[i].x) + bfhi(x[i].x)) + (bflo(x[i].y) + bfhi(x[i].y)) + (bflo(x[i].z) + bfhi(x[i].z)) + (bflo(x[i].w) + bfhi(x[i].w)); }
        s += __shfl_xor(s, 1); s += __shfl_xor(s, 2);
        const float mu = s * (1.0f / 512.0f); float q = 0.f;
#pragma unroll
        for (int i = 0; i < 16; ++i) { float d;
            d = bflo(x[i].x) - mu; q += d * d; d = bfhi(x[i].x) - mu; q += d * d; d = bflo(x[i].y) - mu; q += d * d; d = bfhi(x[i].y) - mu; q += d * d;
            d = bflo(x[i].z) - mu; q += d * d; d = bfhi(x[i].z) - mu; q += d * d; d = bflo(x[i].w) - mu; q += d * d; d = bfhi(x[i].w) - mu; q += d * d; }
        q += __shfl_xor(q, 1); q += __shfl_xor(q, 2);
        const float rs = t_rsq(q * (1.0f / 512.0f) + EPS);
        __syncthreads();
        const LAS float* lg = (const LAS float*)(lds + SG_LN) + 128 * qd; const LAS float* lb = (const LAS float*)(lds + SG_LN + 2048) + 128 * qd;
#pragma unroll
        for (int i = 0; i < 16; ++i) {
            const f32x4 g0 = *(const LAS f32x4*)(lg + 8 * i), g1 = *(const LAS f32x4*)(lg + 8 * i + 4), b0 = *(const LAS f32x4*)(lb + 8 * i), b1 = *(const LAS f32x4*)(lb + 8 * i + 4);
            const int c = 128 * qd + 8 * i;
            VnT[(c + 0) * SG_STR + j] = f2bf((bflo(x[i].x) - mu) * rs * g0[0] + b0[0]); VnT[(c + 1) * SG_STR + j] = f2bf((bfhi(x[i].x) - mu) * rs * g0[1] + b0[1]);
            VnT[(c + 2) * SG_STR + j] = f2bf((bflo(x[i].y) - mu) * rs * g0[2] + b0[2]); VnT[(c + 3) * SG_STR + j] = f2bf((bfhi(x[i].y) - mu) * rs * g0[3] + b0[3]);
            VnT[(c + 4) * SG_STR + j] = f2bf((bflo(x[i].z) - mu) * rs * g1[0] + b1[0]); VnT[(c + 5) * SG_STR + j] = f2bf((bfhi(x[i].z) - mu) * rs * g1[1] + b1[1]);
            VnT[(c + 6) * SG_STR + j] = f2bf((bflo(x[i].w) - mu) * rs * g1[2] + b1[2]); VnT[(c + 7) * SG_STR + j] = f2bf((bfhi(x[i].w) - mu) * rs * g1[3] + b1[3]);
        }
    }
    __syncthreads();
    const int gq = w >> 1, ch = w & 1;
    const bf16_t* Wg = p.sgw + ((size_t)l * 4 + gq) * 128 * 128;
#pragma unroll
    for (int ps = 0; ps < 2; ++ps) {
        f32x4 acc[4][4];
#pragma unroll
        for (int a = 0; a < 4; ++a)
#pragma unroll
            for (int b = 0; b < 4; ++b) acc[a][b] = (f32x4){0.f, 0.f, 0.f, 0.f};
        u32x2 zu[4][4];
#pragma unroll
        for (int ni = 0; ni < 4; ++ni)
#pragma unroll
            for (int mc = 0; mc < 4; ++mc) zu[ni][mc] = *(const u32x2*)(p.Y + (size_t)(r0 + 64 * ps + 16 * ni + fr) * YW + Y_UZ + 128 * gq + 64 * ch + 4 * g + 16 * mc);
        float bsv[4];
#pragma unroll
        for (int ni = 0; ni < 4; ++ni) bsv[ni] = p.sg_b[(l * 4 + gq) * 128 + 64 * ps + 16 * ni + fr];
        __builtin_amdgcn_sched_barrier(0);
        const int nks = ps ? 4 : 2;
#pragma unroll
        for (int ks = 0; ks < nks; ++ks) {
            bf16x8 af[4], bf[4];
#pragma unroll
            for (int mc = 0; mc < 4; ++mc) af[mc] = *(const LAS bf16x8*)(lds + ((128 * gq + 64 * ch + 16 * mc + fr) * SG_STR + 32 * ks + 8 * g) * 2);
#pragma unroll
            for (int ni = 0; ni < 4; ++ni) bf[ni] = *(const bf16x8*)(Wg + (size_t)(64 * ps + 16 * ni + fr) * 128 + 32 * ks + 8 * g);
#pragma unroll
            for (int mc = 0; mc < 4; ++mc)
#pragma unroll
                for (int ni = 0; ni < 4; ++ni) acc[mc][ni] = MFMA16(af[mc], bf[ni], acc[mc][ni]);
        }
#pragma unroll
        for (int ni = 0; ni < 4; ++ni) { const int i = 64 * ps + 16 * ni + fr; const float bs = bsv[ni];
            bf16_t* yo = p.Y + (size_t)(r0 + i) * YW + Y_UZ + 128 * gq + 64 * ch + 4 * g;
            bf16_t* yw = DRY ? p.merged + (size_t)(r0 + i) * D + 128 * gq + 64 * ch + 4 * g : yo;
#pragma unroll
            for (int mc = 0; mc < 4; ++mc) { const u32x2 z = zu[ni][mc];
                u32x2 o; o.x = pk2((acc[mc][ni][0] + bs) * bflo(z.x), (acc[mc][ni][1] + bs) * bfhi(z.x)); o.y = pk2((acc[mc][ni][2] + bs) * bflo(z.y), (acc[mc][ni][3] + bs) * bfhi(z.y));
                *(u32x2*)(yw + 16 * mc) = o; } }
    }
    __syncthreads();
}

__device__ __forceinline__ void attn_unit(const P& p, int bh, int qb, ldsp lds, bool DRY) {
    int tid = threadIdx.x; asm volatile("" : "+v"(tid) :: "memory");
    const int lane = tid & 63, r32 = lane & 31, hi = lane >> 5; const int w = __builtin_amdgcn_readfirstlane(tid >> 6);
    const bf16_t* Qh = p.Q + (size_t)bh * S * 96; const bf16_t* Kh = p.K + (size_t)bh * S * 96; const bf16_t* Vh = p.V + (size_t)bh * S * 64;
    const int q0 = qb * 256 + 32 * w, NT = 4 * qb + 4, tlast = 4 * qb + (w >> 1);
    bf16x8 qf[6];
#pragma unroll
    for (int d0 = 0; d0 < 6; ++d0) qf[d0] = *(const bf16x8*)(Qh + (size_t)(q0 + r32) * 96 + 16 * d0 + 8 * hi);
    const int kk0 = 16 * (w & 3) + (lane >> 2), kc0 = 4 * (w >> 2) + (lane & 3), kk1 = 16 * (w & 3) + (lane >> 2), kc1 = 8 + (lane & 3);
    const bf16_t* ks0 = Kh + (size_t)kk0 * 96 + kc0 * 8; const bf16_t* ks1 = Kh + (size_t)kk1 * 96 + kc1 * 8; const bf16_t* vs = Vh + (size_t)(tid >> 3) * 64 + (tid & 7) * 8;
    const int kd0 = kc0 * 1024 + kk0 * 16, kd1 = kc1 * 1024 + kk1 * 16, vd = 12288 + ((tid & 7) >> 2) * 4096 + (tid >> 3) * 64 + (tid & 3) * 16;
    const bool two = tid < 256;
    u32x4 ak0, ak1 = (u32x4){0u, 0u, 0u, 0u}, av, bk0, bk1 = (u32x4){0u, 0u, 0u, 0u}, bv;
#define ATT_LOAD(K0, K1, V, tt) do { const size_t ko_ = (size_t)(tt) * 64 * 96, vo_ = (size_t)(tt) * 64 * 64; K0 = *(const u32x4*)(ks0 + ko_); if (two) K1 = *(const u32x4*)(ks1 + ko_); V = *(const u32x4*)(vs + vo_); } while (0)
#define ATT_WRITE(K0, K1, V, bo) do { *(LAS u32x4*)(lds + (bo) + kd0) = K0; if (two) *(LAS u32x4*)(lds + (bo) + kd1) = K1; *(LAS u32x4*)(lds + (bo) + vd) = V; } while (0)
    ATT_LOAD(ak0, ak1, av, 0); ATT_LOAD(bk0, bk1, bv, 1);
    if (w < 4) __builtin_amdgcn_s_setprio(2);
    ATT_WRITE(ak0, ak1, av, 0);
    __syncthreads();
    f32x16 o0, o1;
#pragma unroll
    for (int r = 0; r < 16; ++r) { o0[r] = 0.f; o1[r] = 0.f; }
    f32x16 lacc;
#pragma unroll
    for (int r = 0; r < 16; ++r) lacc[r] = 0.f;
    const bf16x8 ones8 = (bf16x8){(short)0x3f80, (short)0x3f80, (short)0x3f80, (short)0x3f80, (short)0x3f80, (short)0x3f80, (short)0x3f80, (short)0x3f80};
    float mref = 0.f, lrun = 0.f;
    f32x16 negm;
#pragma unroll
    for (int r = 0; r < 16; ++r) negm[r] = 0.f;
    const int vb = 12288 + ((lane >> 4) & 1) * 32 + (lane & 3) * 8 + (4 * hi + ((lane & 15) >> 2)) * 64;
#define ATT_STEP(t, cur) do { \
            if (t <= tlast) { \
                bf16x8 kf[12]; \
    _Pragma("unroll") \
                for (int i = 0; i < 12; ++i) kf[i] = *(const LAS bf16x8*)(lds + cur + (2 * (i >> 1) + hi) * 1024 + (i & 1) * 512 + r32 * 16);     \
                __builtin_amdgcn_sched_barrier(0); \
                f32x16 p0 = MFMA32(kf[0], qf[0], negm), p1 = MFMA32(kf[1], qf[0], negm); \
    _Pragma("unroll") \
                for (int d0 = 1; d0 < 6; ++d0) { p0 = MFMA32(kf[2 * d0], qf[d0], p0); p1 = MFMA32(kf[2 * d0 + 1], qf[d0], p1); } \
                s16x4 vf[16];                                                \
    _Pragma("unroll") \
                for (int ks = 0; ks < 4; ++ks) { \
                    vf[4 * ks + 0] = __builtin_bit_cast(s16x4, __builtin_amdgcn_ds_read_tr16_b64_v4i16((LAS v4i16_t*)(lds + cur + vb + ks * 1024))); \
                    vf[4 * ks + 1] = __builtin_bit_cast(s16x4, __builtin_amdgcn_ds_read_tr16_b64_v4i16((LAS v4i16_t*)(lds + cur + vb + ks * 1024 + 512))); \
                    vf[4 * ks + 2] = __builtin_bit_cast(s16x4, __builtin_amdgcn_ds_read_tr16_b64_v4i16((LAS v4i16_t*)(lds + cur + vb + 4096 + ks * 1024))); \
                    vf[4 * ks + 3] = __builtin_bit_cast(s16x4, __builtin_amdgcn_ds_read_tr16_b64_v4i16((LAS v4i16_t*)(lds + cur + vb + 4096 + ks * 1024 + 512))); \
                } \
                __builtin_amdgcn_sched_barrier(0); \
                float mxa = fmaxf(fmaxf(p0[0], p0[1]), p1[0]), mxb = fmaxf(fmaxf(p0[2], p0[3]), p1[1]); mxa = fmaxf(fmaxf(mxa, p1[2]), p1[3]); \
    _Pragma("unroll") \
                for (int r = 4; r < 16; r += 4) { mxa = fmaxf(fmaxf(mxa, p0[r]), p0[r + 1]); mxb = fmaxf(fmaxf(mxb, p0[r + 2]), p0[r + 3]); mxa = fmaxf(fmaxf(mxa, p1[r]), p1[r + 1]); mxb = fmaxf(fmaxf(mxb, p1[r + 2]), p1[r + 3]); } \
                float mx = fmaxf(mxa, mxb); mx = fmaxf(mx, __shfl_xor(mx, 32)); \
                if (__builtin_expect((t) == 0 || __any(mx > 8.0f), 0)) {       \
                    const float dl = ((t) == 0) ? mx : fmaxf(mx, 0.f), f = t_exp2(-dl); mref += dl; \
    _Pragma("unroll") \
                    for (int r = 0; r < 16; ++r) { p0[r] -= dl; p1[r] -= dl; negm[r] = -mref; o0[r] *= f; o1[r] *= f; lacc[r] *= f; } \
                } \
    _Pragma("unroll") \
                for (int r = 0; r < 16; ++r) { p0[r] = t_exp2(p0[r]); p1[r] = t_exp2(p1[r]); } \
                u32x4 pw[4]; \
                pw[0] = (u32x4){pk2(p0[0], p0[1]), pk2(p0[2], p0[3]), pk2(p0[4], p0[5]), pk2(p0[6], p0[7])}; \
                pw[1] = (u32x4){pk2(p0[8], p0[9]), pk2(p0[10], p0[11]), pk2(p0[12], p0[13]), pk2(p0[14], p0[15])}; \
                pw[2] = (u32x4){pk2(p1[0], p1[1]), pk2(p1[2], p1[3]), pk2(p1[4], p1[5]), pk2(p1[6], p1[7])}; \
                pw[3] = (u32x4){pk2(p1[8], p1[9]), pk2(p1[10], p1[11]), pk2(p1[12], p1[13]), pk2(p1[14], p1[15])}; \
    _Pragma("unroll") \
                for (int ks = 0; ks < 4; ++ks) { \
                    const bf16x8 pf = __builtin_bit_cast(bf16x8, pw[ks]); \
                    const s16x4 a0 = vf[4 * ks], a1 = vf[4 * ks + 1], b0 = vf[4 * ks + 2], b1 = vf[4 * ks + 3]; \
                    const bf16x8 va = (bf16x8){a0[0], a0[1], a0[2], a0[3], a1[0], a1[1], a1[2], a1[3]}, vbb = (bf16x8){b0[0], b0[1], b0[2], b0[3], b1[0], b1[1], b1[2], b1[3]}; \
                    o0 = MFMA32(va, pf, o0); o1 = MFMA32(vbb, pf, o1); lacc = MFMA32(ones8, pf, lacc); \
                } \
            } \
    } while (0)
    for (int t0 = 0; t0 < NT; t0 += 2) {
        if (t0 + 2 < NT) ATT_LOAD(ak0, ak1, av, t0 + 2);
        ATT_STEP(t0, 0);
        ATT_WRITE(bk0, bk1, bv, 20480);
        asm volatile("s_waitcnt lgkmcnt(0)\n\ts_barrier" ::: "memory");
        if (t0 + 3 < NT) ATT_LOAD(bk0, bk1, bv, t0 + 3);
        ATT_STEP(t0 + 1, 20480);
        if (t0 + 2 < NT) ATT_WRITE(ak0, ak1, av, 0);
        asm volatile("s_waitcnt lgkmcnt(0)\n\ts_barrier" ::: "memory");
    }
    __builtin_amdgcn_s_setprio(0);
#undef ATT_LOAD
#undef ATT_WRITE
#undef ATT_STEP
    lrun = lacc[0];
    const float il = t_rcp(lrun);
    const int bl = bh >> 3, h = bh & 7;
    bf16_t* yo = p.Y + (size_t)(bl * S + q0 + r32) * YW + Y_ZB + h * 64 + 4 * hi;
    bf16_t* yw = DRY ? p.merged + (size_t)(bl * S + q0 + r32) * D + h * 64 + 4 * hi : yo;
    u32x2 zb[4][2];
#pragma unroll
    for (int a = 0; a < 4; ++a) { zb[a][0] = *(const u32x2*)(yo + 8 * a); zb[a][1] = *(const u32x2*)(yo + 32 + 8 * a); }
    __builtin_amdgcn_sched_barrier(0);
#pragma unroll
    for (int a = 0; a < 4; ++a) {
        { const u32x2 z = zb[a][0]; u32x2 o; o.x = pk2(o0[4 * a] * il * bflo(z.x), o0[4 * a + 1] * il * bfhi(z.x)); o.y = pk2(o0[4 * a + 2] * il * bflo(z.y), o0[4 * a + 3] * il * bfhi(z.y)); *(u32x2*)(yw + 8 * a) = o; }
        { const u32x2 z = zb[a][1]; u32x2 o; o.x = pk2(o1[4 * a] * il * bflo(z.x), o1[4 * a + 1] * il * bfhi(z.x)); o.y = pk2(o1[4 * a + 2] * il * bflo(z.y), o1[4 * a + 3] * il * bfhi(z.y)); *(u32x2*)(yw + 32 + 8 * a) = o; }
    }
}
}

namespace fx {
template <int PH> __device__ __forceinline__ void run_phase(const P& p, int l, int sl, ldsp lds, bool DRY = false, int half = -1, int part = 3) {
    const int G = gridDim.x, bx = blockIdx.x;
    const int TH = (half < 0) ? T : T / 2, rofs = (half == 1) ? T / 2 : 0;
    if constexpr (PH == 0) { p0_prologue(p, lds); }
    if constexpr (PH == 2) {
        pg8::Gemm g{p.xb + ((size_t)sl * T + rofs) * D, p.Win_t + (size_t)l * NP * D, D, D, (DRY && FX_TIME_PH == 22) ? D / 2 : D, 0, 0, (DRY && FX_TIME_PH == 23) ? 0 : -1};
        pg8::StaticOrder So; So.init(TH, NP, G, bx);
        EpiIn E{p.Y + (size_t)rofs * YW, p.rstd + (size_t)sl * T + rofs, p.b_gate + l * 3 * D, p.GT + (size_t)(rofs / 256) * 12 * 16 * 512};
        pg8::gemm_phase<EpiIn, pg8::StaticOrder>(lds, g, So, E);
    }
    if constexpr (PH == 3) {
        if (half <= 0) { if (sl > 0) { if (l + 1 < DEPTH) p8_rstd(p, sl - 1); } else if (l > 0) p8_rstd(p, NSL - 1); }
        if (part & 1)
        for (int rp = (FX_TIME_PH == 31) ? 1 : 0; rp >= 0; --rp)
        mla_units128(p, l, sl, rofs / 128 + bx, G, (rofs + TH) / 128, lds);
        if (part & 2)
        for (int rp = (FX_TIME_PH == 32) ? 1 : 0; rp >= 0; --rp)
        for (int u = rofs / 64 + bx; u < (rofs + TH) / 64; u += G) { if (FX_SYNCU & 2) __syncthreads(); gla_a_unit(p, l, u, lds); }
    }
    if constexpr (PH == 4) {
        for (int rp = (FX_TIME_PH == 41) ? 1 : 0; rp >= 0; --rp)
        if (half <= 0) gla_scan(p);
        const int vcu = (G % 8 == 0) ? (bx % 8) * (G / 8) + bx / 8 : bx;
        for (int pr = (half == 1 ? SLB * 32 : 0) + vcu; pr < ((half == 0) ? SLB * 32 : SLB * 64); pr += G) {
            const int bh = pr >> 3, s = pr & 7;
            attn_unit(p, bh, s, lds, DRY); attn_unit(p, bh, 15 - s, lds, DRY);
        }
    }
    if constexpr (PH == 5) {
        for (int rp = (FX_TIME_PH == 51) ? 1 : 0; rp >= 0; --rp)
        for (int u = rofs / 64 + bx; u < (rofs + TH) / 64; u += G) gla_b_unit(p, l, u, lds, DRY || rp);
        for (int rp = (FX_TIME_PH == 52) ? 1 : 0; rp >= 0; --rp)
        for (int u = rofs / 128 + bx; u < (rofs + TH) / 128; u += G) sg_unit(p, l, u, lds, DRY || rp);
    }
    if constexpr (PH == 6) {
        pg8::Gemm g{p.Y + (size_t)rofs * YW, p.Wbr_t + (size_t)l * 3 * D * 512, YW, 512, 512, 1536 * 2, (long)D * 512 * 2};
        pg8::StaticOrderT<3> So; So.init(TH, D, G, bx);
        EpiMerge E{p.GT + (size_t)(rofs / 256) * 12 * 16 * 512, p.merged + (size_t)rofs * D};
        pg8::gemm_phase<EpiMerge, pg8::StaticOrderT<3>>(lds, g, So, E);
    }
    if constexpr (PH == 7) {
        pg8::Gemm g{p.merged + (size_t)rofs * D, p.Wout_t + (size_t)l * D * D, D, D, D, 0, 0};
        pg8::StaticOrder So; So.init(TH, D, G, bx);
        const size_t ro = (size_t)sl * T + rofs;
        EpiOut E{p.x_in + ro * D, DRY ? (float*)p.Q : p.out + ro * D, p.xb + ro * D, DRY ? p.UT : p.xb + ro * D, DRY ? (float*)p.Y : p.ssq + ro * 128, l == 0, l == DEPTH - 1};
        pg8::gemm_phase<EpiOut, pg8::StaticOrder>(lds, g, So, E);
    }
}

template <int PH> __global__ void __launch_bounds__(512, 2) FX_NOPK k_ph(P p, int l, int sl, int dry, int half, int part) {
    extern __shared__ __attribute__((aligned(16))) unsigned char smem[];
    run_phase<PH>(p, l, sl, (ldsp)smem, dry != 0, half, part);
}

__global__ void __launch_bounds__(512, 2) FX_NOPK k_mega(P p) {
    extern __shared__ __attribute__((aligned(16))) unsigned char smem[];
    ldsp lds = (ldsp)smem;
    if (threadIdx.x < 4) ((LAS unsigned*)(lds + LDS_BARW))[threadIdx.x] = 0u;
    __syncthreads();
    XcdBarrier bar = xcd_barrier_post(p.bar, (volatile LAS unsigned*)(lds + LDS_BARW));
#define GRID_BAR() do { XcdBarrier b_ = bar; asm volatile("" : "+s"(b_.x)); xcd_barrier(b_); } while (0)
    run_phase<0>(p, 0, 0, lds); GRID_BAR();
    for (int l = 0; l < DEPTH; ++l) {
        for (int sl = 0; sl < NSL; ++sl) {
            run_phase<2>(p, l, sl, lds); GRID_BAR();
            run_phase<3>(p, l, sl, lds); GRID_BAR();
            run_phase<4>(p, l, sl, lds); GRID_BAR();
            run_phase<5>(p, l, sl, lds); GRID_BAR();
            run_phase<6>(p, l, sl, lds); GRID_BAR();
            run_phase<7>(p, l, sl, lds);
        }
    }
}
}


extern "C" void kernel_launch(void* const* d_in, const int* in_sizes, int n_in, void* d_out, int out_size, void* d_ws, size_t ws_size, hipStream_t stream) {
    using namespace fx;
    static int grid = 0;
    if (grid == 0) {
        int dev = 0, cus = 0;
        if (hipGetDevice(&dev) != hipSuccess || hipDeviceGetAttribute(&cus, hipDeviceAttributeMultiprocessorCount, dev) != hipSuccess) { fprintf(stderr, "kernel_launch: device query failed\n"); grid = -1; return; }
        hipError_t e = hipFuncSetAttribute((const void*)k_mega, hipFuncAttributeMaxDynamicSharedMemorySize, LDS_BYTES);
        if (e != hipSuccess) { fprintf(stderr, "kernel_launch: hipFuncSetAttribute failed\n"); grid = -1; return; }
        int occ = 0;
        if (hipOccupancyMaxActiveBlocksPerMultiprocessor(&occ, (const void*)k_mega, 512, LDS_BYTES) != hipSuccess || occ < 1) { fprintf(stderr, "kernel_launch: occupancy query failed\n"); grid = -1; return; }
        grid = cus;
    }
    if (grid < 0) return;
    size_t off = 0; unsigned char* ws = (unsigned char*)d_ws;
    auto take = [&](size_t n) { unsigned char* q = ws + off; off += (n + 255) & ~(size_t)255; return q; };
    P p{};
    p.x_in = (const float*)d_in[0]; p.pos = (const int*)d_in[1]; p.norm_g = (const float*)d_in[2]; p.w_in = (const float*)d_in[3]; p.b_gate = (const float*)d_in[4];
    p.sg_ln_g = (const float*)d_in[5]; p.sg_ln_b = (const float*)d_in[6]; p.sg_w = (const float*)d_in[7]; p.sg_b = (const float*)d_in[8];
    p.cq_g = (const float*)d_in[9]; p.ckv_g = (const float*)d_in[10]; p.w_uq = (const float*)d_in[11]; p.w_ukv = (const float*)d_in[12]; p.q_g = (const float*)d_in[13]; p.k_g = (const float*)d_in[14];
    p.w_gate = (const float*)d_in[15]; p.bg_gate = (const float*)d_in[16]; p.o_g = (const float*)d_in[17]; p.w_branch = (const float*)d_in[18]; p.w_out = (const float*)d_in[19];
    p.out = (float*)d_out;
    p.bar = (unsigned*)take(16384);
    p.xb = (bf16_t*)take((size_t)NB * S * D * 2); p.rstd = (float*)take((size_t)NB * S * 4); p.ssq = (float*)take((size_t)NB * S * 4 * 32 * 4);
    p.Y = (bf16_t*)take((size_t)T * YW * 2);
    p.Q = (bf16_t*)take((size_t)SLB * 8 * S * 96 * 2); p.K = (bf16_t*)take((size_t)SLB * 8 * S * 96 * 2); p.V = (bf16_t*)take((size_t)SLB * 8 * S * 64 * 2);
    p.UT = (bf16_t*)take((size_t)SLB * 4 * 64 * 8192 * 2); p.ST = (bf16_t*)take((size_t)SLB * 4 * 64 * 8192 * 2); p.dec = (float*)take((size_t)SLB * 4 * 64 * 64 * 4);
    p.merged = (bf16_t*)take((size_t)T * D * 2); p.GT = (pg8::u32x2*)take((size_t)T * 3 * D);
    p.Win_t = (bf16_t*)take((size_t)DEPTH * NP * D * 2); p.Wuq_t = (bf16_t*)take((size_t)DEPTH * 768 * 256 * 2); p.Wukv_t = (bf16_t*)take((size_t)DEPTH * 1024 * 128 * 2);
    p.Wbr_t = (bf16_t*)take((size_t)DEPTH * 3 * D * 512 * 2); p.Wout_t = (bf16_t*)take((size_t)DEPTH * D * D * 2); p.sgw = (bf16_t*)take((size_t)DEPTH * 4 * 128 * 128 * 2);
    p.cs = (float*)take((size_t)NB * S * 16 * 4); p.sn = (float*)take((size_t)NB * S * 16 * 4);
    if (off > ws_size) { fprintf(stderr, "kernel_launch: workspace too small: need %zu have %zu\n", off, ws_size); return; }
    (void)hipMemsetAsync(p.bar, 0, 16384, stream);
    hipLaunchKernelGGL(k_mega, dim3(grid), dim3(512), LDS_BYTES, stream, p);
}
```

```cpp
#include <hip/hip_runtime.h>
#include <cstdio>
#include <cstdint>
#define FX_DEBUG 0
#define FX_DEBUG_SEL (-1)
#define FX_MULTI 0
#define FX_SLB 8
#define FX_DEBUG_TOL 0.03f
#define FX_TIME_PH 0
#define FX_ZEROWS 0
#define FX_HOLE 0
#define FX_SPLIT 0
#define FX_SYNCU 0
#define FX_PARTS 0
#define FX_CKSUM 0
#define FX_TWICE 0
#define FX_CKIDX (-1)
#define FX_CKN 64
#define FX_EXP 0
#define FX_CKDIV 1
#define FX_CKSUB 0
#define FX_SELFCHK 0
#define FX_NOPK __attribute__((target("no-packed-fp32-ops")))
#define FX_SELOFF 0

#define XB_TMO      128
#define XB_XCNT(j)  (256  + 64 * (j))
#define XB_XSUB(j)  (1280 + 64 * (j))
#define XB_XGEN(j)  (2304 + 64 * (j))
#define XB_TOP      3328
#define XB_TOPGEN   3392
#define XCD_BAR_WORDS 3456
#define XB_SPIN_CAP (1u << 18)
#define LAS __attribute__((address_space(3)))

__device__ __forceinline__ unsigned xb_ld(unsigned* p)              { return __hip_atomic_load(p, __ATOMIC_RELAXED, __HIP_MEMORY_SCOPE_AGENT); }
__device__ __forceinline__ unsigned xb_add(unsigned* p, unsigned v) { return __hip_atomic_fetch_add(p, v, __ATOMIC_RELAXED, __HIP_MEMORY_SCOPE_AGENT); }
__device__ __forceinline__ unsigned xb_xcc_id() { return (unsigned)__builtin_amdgcn_s_getreg((3 << 11) | 20) & 0xFu; }
#define XB_SPIN(cond, bar) do { unsigned _sp = 0; while (cond) { __builtin_amdgcn_s_sleep(1); \
    if ((++_sp & 255u) == 0u) { if (xb_ld(&(bar)[XB_TMO])) break; if (_sp > XB_SPIN_CAP) { atomicAdd(&(bar)[XB_TMO], 1u); break; } } } } while (0)

struct XcdBarrier {
    unsigned* bar; unsigned x;
    volatile LAS unsigned* st;
};

__device__ __forceinline__ XcdBarrier xcd_barrier_post(unsigned* bar, volatile LAS unsigned* st) {
    XcdBarrier b; b.bar = bar; b.x = xb_xcc_id(); b.st = st;
    if (threadIdx.x == 0) (void)xb_add(&bar[XB_XCNT(b.x)], 1u);
    return b;
}
__device__ __forceinline__ void xcd_barrier_complete(unsigned* bar, unsigned x, unsigned& nloc, unsigned& nx) {
    const unsigned G = gridDim.x * gridDim.y * gridDim.z;
    unsigned sum, cnt, mine, sp = 0u;
    for (;;) {
        sum = 0u; cnt = 0u; mine = 0u;
#pragma unroll
        for (unsigned j = 0; j < 16; ++j) { const unsigned c = xb_ld(&bar[XB_XCNT(j)]); sum += c; cnt += (c > 0u) ? 1u : 0u; mine = (j == x) ? c : mine; }
        if (sum == G) break;
        __builtin_amdgcn_s_sleep(1);
        if ((++sp & 255u) == 0u) { if (xb_ld(&bar[XB_TMO])) break; if (sp > XB_SPIN_CAP) { atomicAdd(&bar[XB_TMO], 1u); break; } }
    }
    nloc = mine > 0u ? mine : 1u; nx = cnt > 0u ? cnt : 1u;
}

__device__ __forceinline__ void xcd_barrier(const XcdBarrier& b) {
    asm volatile("s_waitcnt vmcnt(0)" ::: "memory");
    __syncthreads();
    if (threadIdx.x == 0) {
        unsigned* bar = b.bar;
        __builtin_amdgcn_s_waitcnt(0);
        unsigned nloc = b.st[0], nx = b.st[1];
        if (nloc == 0u) { xcd_barrier_complete(bar, b.x, nloc, nx); b.st[0] = nloc; b.st[1] = nx; }
        const unsigned old = xb_add(&bar[XB_XSUB(b.x)], 1u);
        const unsigned gen = old / nloc;
        if (old + 1u == (gen + 1u) * nloc) {
            __builtin_amdgcn_fence(__ATOMIC_RELEASE, "agent");
            asm volatile("s_waitcnt vmcnt(0)" ::: "memory");
            const unsigned og = xb_add(&bar[XB_TOP], 1u);
            const unsigned tg = og / nx;
            if (og + 1u == (tg + 1u) * nx) xb_add(&bar[XB_TOPGEN], 1u);
            else XB_SPIN(xb_ld(&bar[XB_TOPGEN]) == tg, bar);
            __builtin_amdgcn_fence(__ATOMIC_ACQUIRE, "agent");
            xb_add(&bar[XB_XGEN(b.x)], 1u);
            asm volatile("s_waitcnt vmcnt(0)" ::: "memory");
        } else {
            XB_SPIN(xb_ld(&bar[XB_XGEN(b.x)]) == gen, bar);
            __builtin_amdgcn_fence(__ATOMIC_ACQUIRE, "agent");
            asm volatile("s_waitcnt vmcnt(0)" ::: "memory");
        }
    }
    __syncthreads();
}

namespace pg8 {
#define PG8_LAS __attribute__((address_space(3)))
typedef unsigned short bf16_t;
typedef short bf16x8 __attribute__((ext_vector_type(8)));
typedef float f32x4 __attribute__((ext_vector_type(4)));
typedef unsigned u32x4 __attribute__((ext_vector_type(4)));
typedef unsigned u32x2 __attribute__((ext_vector_type(2)));
constexpr int BM = 256, BK = 64, HALF = 128, HTB = HALF * BK * 2  , STAGE_BYTES = 8 * HTB, NXCD = 8, WGM = 8;

__host__ __device__ __forceinline__ int lds_byte(int r, int c) { const int st = (r >> 4) * 2 + (c >> 5), rr = r & 15, cc = c & 31, ob = rr * 64 + cc * 2; return st * 1024 + (ob ^ (((ob >> 9) & 1) << 5)); }
__host__ __device__ __forceinline__ void stage_rc(int b, int& R, int& C) { const int st = b / 1024, sb = b % 1024, swz = sb ^ (((sb >> 9) & 1) << 5); R = (st >> 1) * 16 + swz / 64; C = (st & 1) * 32 + (swz % 64) / 2; }
__host__ __device__ __forceinline__ int perm32(int rho) { const int n = rho >> 4, i = rho & 15; return 8 * (i >> 2) + 4 * n + (i & 3); }

struct Unit { int pm, pn, br, keep; };
struct Gemm { const bf16_t* A; const bf16_t* Bt; int lda, ldb, K; long abr, bbr; int umask = -1; };

template <int CH> struct StaticOrderT {
    int nM, nN, nwg, G, c;
    __host__ __device__ void init(int M, int N, int G_, int c_) { nM = M / BM; nN = N / BM; nwg = nM * nN; G = G_; c = c_; }
    __host__ __device__ bool next(int i, Unit& u) const {
        const int r = i / CH, br = i % CH;
        const long L = (long)r * G + c; if (L >= nwg) return false;
        int wgid = (int)L; { const int q = nwg / NXCD, rr = nwg % NXCD, xcd = wgid % NXCD, off = wgid / NXCD; wgid = (xcd < rr ? xcd * (q + 1) : rr * (q + 1) + (xcd - rr) * q) + off; }
        const int nig = WGM * nN, gid = wgid / nig, fm = gid * WGM, gsz = (nM - fm) < WGM ? (nM - fm) : WGM;
        u.pm = fm + ((wgid % nig) % gsz); u.pn = (wgid % nig) / gsz; u.br = br; u.keep = (br < CH - 1) ? 1 : 0; return true;
    }
};
typedef StaticOrderT<1> StaticOrder;

__device__ __forceinline__ unsigned cvt_pk_bf16(float lo, float hi) { unsigned r; asm volatile("v_cvt_pk_bf16_f32 %0, %1, %2" : "=v"(r) : "v"(lo), "v"(hi)); return r; }

template <class Epi, class Sched, bool ALIGN_EPI = true, bool SP2 = true>
__device__ __forceinline__ void gemm_phase(PG8_LAS unsigned char* lds, const Gemm g, const Sched& S, const Epi& E) {
    int tid = threadIdx.x; asm volatile("" : "+v"(tid));
    const int wid = __builtin_amdgcn_readfirstlane(tid >> 6), lane = tid & 63, wr = wid >> 2, wc = wid & 3, fr = lane & 15, fq = lane >> 4;
    const int K = g.K, nt = K / BK;
    unsigned voffA[2], voffB[2];
#pragma unroll
    for (int i = 0; i < 2; ++i) { int R, C; stage_rc(tid * 16 + i * 8192, R, C); const int Rb = Epi::PERM ? ((R & ~31) + perm32(R & 31)) : R;
        voffA[i] = (unsigned)(R * g.lda + C) * 2u; voffB[i] = (unsigned)(Rb * g.ldb + C) * 2u; }
    const size_t kstep = (size_t)(BK * 2);
    const size_t hstepA = (size_t)HALF * g.lda * 2, hstepB = (size_t)HALF * g.ldb * 2;
    const size_t tstepA = 2 * hstepA, tstepB = 2 * hstepB;
    const unsigned ldsw = (unsigned)wid * 1024u;
    const int aoff = lds_byte(wr * 64 + fr, fq * 8), boff = lds_byte(wc * 32 + fr, fq * 8);
#define PG8_SA(b, h) (((b) * 2 + (h)) * HTB)
#define PG8_SB(b, h) ((4 + (b) * 2 + (h)) * HTB)
#define PG8_STAGE(bufoff, gbase, voff) do { _Pragma("unroll") for (int _i = 0; _i < 2; ++_i) \
        __builtin_amdgcn_global_load_lds((const unsigned*)((const char*)(gbase) + (voff)[_i]), (PG8_LAS unsigned*)(lds + (bufoff) + ldsw + _i * 8192), 16, 0, 0); } while (0)
#define PG8_LDA(dst, b, h) do { _Pragma("unroll") for (int m = 0; m < 4; ++m) _Pragma("unroll") for (int k = 0; k < 2; ++k) dst[m][k] = *(const PG8_LAS bf16x8*)(lds + PG8_SA(b, h) + aoff + m * 2048 + k * 1024); } while (0)
#define PG8_LDB(dst, b, h) do { _Pragma("unroll") for (int n = 0; n < 2; ++n) _Pragma("unroll") for (int k = 0; k < 2; ++k) dst[n][k] = *(const PG8_LAS bf16x8*)(lds + PG8_SB(b, h) + boff + n * 2048 + k * 1024); } while (0)
#define PG8_MMA(ai, bj, At, Bt) do { __builtin_amdgcn_s_setprio(1); _Pragma("unroll") for (int m = 0; m < 4; ++m) _Pragma("unroll") for (int n = 0; n < 2; ++n) _Pragma("unroll") for (int k = 0; k < 2; ++k) \
        acc[ai][bj][m][n] = __builtin_amdgcn_mfma_f32_16x16x32_bf16(Bt[n][k], At[m][k], acc[ai][bj][m][n], 0, 0, 0); __builtin_amdgcn_s_setprio(0); } while (0)
#define PG8_WAIT_V(n) asm volatile("s_waitcnt vmcnt(" #n ")" ::: "memory")
#define PG8_WAIT_L(n) asm volatile("s_waitcnt lgkmcnt(" #n ")" ::: "memory")
#define PG8_BAR __builtin_amdgcn_s_barrier()
#define PG8_SCHED __builtin_amdgcn_sched_barrier(0)
    Unit cur, nxt; int ui = 0;
    if (!S.next(0, cur)) return;
    f32x4 acc[2][2][4][2];
#pragma unroll
    for (int a = 0; a < 2; ++a)
#pragma unroll
        for (int b = 0; b < 2; ++b)
#pragma unroll
            for (int m = 0; m < 4; ++m)
#pragma unroll
                for (int n = 0; n < 2; ++n) acc[a][b][m][n] = (f32x4){0.f, 0.f, 0.f, 0.f};
    bf16x8 At[4][2], B0[2][2], B1[2][2];
    const char* cA = (const char*)g.A + (size_t)cur.br * g.abr + (size_t)(cur.pm & g.umask) * tstepA; const char* cB = (const char*)g.Bt + (size_t)cur.br * g.bbr + (size_t)(cur.pn & g.umask) * tstepB;
    if constexpr (SP2) {
        PG8_STAGE(PG8_SB(0, 0), cB, voffB); PG8_STAGE(PG8_SB(0, 1), cB + hstepB, voffB); PG8_STAGE(PG8_SA(0, 0), cA, voffA); PG8_STAGE(PG8_SA(0, 1), cA + hstepA, voffA);
        if (wr == 1) PG8_BAR;
        PG8_WAIT_V(2); PG8_BAR;
        PG8_STAGE(PG8_SB(1, 0), cB + kstep, voffB); PG8_STAGE(PG8_SA(1, 0), cA + kstep, voffA); PG8_STAGE(PG8_SB(1, 1), cB + hstepB + kstep, voffB);
        PG8_WAIT_V(6); PG8_BAR;
    } else {
        PG8_STAGE(PG8_SB(0, 0), cB, voffB); PG8_STAGE(PG8_SA(0, 0), cA, voffA); PG8_STAGE(PG8_SB(0, 1), cB + hstepB, voffB); PG8_STAGE(PG8_SA(0, 1), cA + hstepA, voffA);
        if (wr == 1) PG8_BAR;
        PG8_WAIT_V(4); PG8_BAR;
        PG8_STAGE(PG8_SB(1, 0), cB + kstep, voffB); PG8_STAGE(PG8_SA(1, 0), cA + kstep, voffA); PG8_STAGE(PG8_SB(1, 1), cB + hstepB + kstep, voffB);
        PG8_WAIT_V(6); PG8_BAR;
    }
    for (;;) {
        const bool has_next = S.next(ui + 1, nxt);
        const char* nA = has_next ? (const char*)g.A + (size_t)nxt.br * g.abr + (size_t)(nxt.pm & g.umask) * tstepA : cA; const char* nB = has_next ? (const char*)g.Bt + (size_t)nxt.br * g.bbr + (size_t)(nxt.pn & g.umask) * tstepB : cB;
        for (int t = 0; t < nt; t += 2) {
            const bool last = (t == nt - 2);
            const char* a1 = cA + (size_t)(t + 1) * kstep;
            const char* a2 = last ? nA : cA + (size_t)(t + 2) * kstep; const char* b2 = last ? nB : cB + (size_t)(t + 2) * kstep;
            const char* a3 = a2 + kstep; const char* b3 = b2 + kstep;
            if constexpr (SP2) {
            PG8_LDB(B0, 0, 0); PG8_LDB(B1, 0, 1); PG8_SCHED; PG8_LDA(At, 0, 0); PG8_STAGE(PG8_SA(1, 1), a1 + hstepA, voffA);
            PG8_WAIT_V(8); PG8_WAIT_L(0); PG8_BAR; PG8_MMA(0, 0, At, B0); PG8_MMA(0, 1, At, B1); PG8_BAR; PG8_SCHED;
            PG8_LDA(At, 0, 1); PG8_STAGE(PG8_SB(0, 0), b2, voffB); PG8_STAGE(PG8_SB(0, 1), b2 + hstepB, voffB); PG8_STAGE(PG8_SA(0, 0), a2, voffA);
            PG8_WAIT_V(8); PG8_WAIT_L(0); PG8_BAR; PG8_MMA(1, 0, At, B0); PG8_MMA(1, 1, At, B1); PG8_BAR; PG8_SCHED;
            PG8_LDB(B0, 1, 0); PG8_LDB(B1, 1, 1); PG8_SCHED; PG8_LDA(At, 1, 0); PG8_STAGE(PG8_SA(0, 1), a2 + hstepA, voffA);
            PG8_WAIT_V(8); PG8_WAIT_L(0); PG8_BAR; PG8_MMA(0, 0, At, B0); PG8_MMA(0, 1, At, B1); PG8_BAR; PG8_SCHED;
            PG8_LDA(At, 1, 1); PG8_STAGE(PG8_SB(1, 0), b3, voffB); PG8_STAGE(PG8_SB(1, 1), b3 + hstepB, voffB); PG8_STAGE(PG8_SA(1, 0), a3, voffA);
            PG8_WAIT_V(8); PG8_WAIT_L(0); PG8_BAR; PG8_MMA(1, 0, At, B0); PG8_MMA(1, 1, At, B1); PG8_BAR; PG8_SCHED;
            } else {
            PG8_LDB(B0, 0, 0); PG8_SCHED; PG8_LDA(At, 0, 0); PG8_STAGE(PG8_SA(1, 1), a1 + hstepA, voffA);
            PG8_WAIT_L(8); PG8_BAR; PG8_WAIT_L(0); PG8_MMA(0, 0, At, B0); PG8_BAR; PG8_SCHED;
            PG8_LDB(B1, 0, 1); PG8_STAGE(PG8_SB(0, 0), b2, voffB);
            PG8_BAR; PG8_WAIT_L(0); PG8_MMA(0, 1, At, B1); PG8_BAR;
            PG8_LDA(At, 0, 1); PG8_STAGE(PG8_SA(0, 0), a2, voffA);
            PG8_BAR; PG8_WAIT_L(0); PG8_MMA(1, 0, At, B0); PG8_BAR; PG8_SCHED;
            PG8_STAGE(PG8_SB(0, 1), b2 + hstepB, voffB);
            PG8_WAIT_V(6); PG8_BAR; PG8_MMA(1, 1, At, B1); PG8_BAR;
            PG8_LDB(B0, 1, 0); PG8_SCHED; PG8_LDA(At, 1, 0); PG8_STAGE(PG8_SA(0, 1), a2 + hstepA, voffA);
            PG8_WAIT_L(8); PG8_BAR; PG8_WAIT_L(0); PG8_MMA(0, 0, At, B0); PG8_BAR; PG8_SCHED;
            PG8_LDB(B1, 1, 1); PG8_STAGE(PG8_SB(1, 0), b3, voffB);
            PG8_BAR; PG8_WAIT_L(0); PG8_MMA(0, 1, At, B1); PG8_BAR;
            PG8_LDA(At, 1, 1); PG8_STAGE(PG8_SA(1, 0), a3, voffA);
            PG8_BAR; PG8_WAIT_L(0); PG8_MMA(1, 0, At, B0); PG8_BAR; PG8_SCHED;
            PG8_STAGE(PG8_SB(1, 1), b3 + hstepB, voffB);
            PG8_WAIT_V(6); PG8_BAR; PG8_MMA(1, 1, At, B1); PG8_BAR;
                    }
        }
        if constexpr (ALIGN_EPI) { if (wr == 0) PG8_BAR; }
        if constexpr (Epi::TWICE) E(acc, cur, wr, wc, fr, fq);
        E(acc, cur, wr, wc, fr, fq);
        if (!has_next) break;
        if (!cur.keep) {
#pragma unroll
            for (int a = 0; a < 2; ++a)
#pragma unroll
                for (int b = 0; b < 2; ++b)
#pragma unroll
                    for (int m = 0; m < 4; ++m)
#pragma unroll
                        for (int n = 0; n < 2; ++n) acc[a][b][m][n] = (f32x4){0.f, 0.f, 0.f, 0.f};
        }
        cur = nxt; cA = nA; cB = nB; ++ui;
        if constexpr (ALIGN_EPI) { if (wr == 1) PG8_BAR; }
    }
    PG8_WAIT_V(0);
    if constexpr (!ALIGN_EPI) { if (wr == 0) PG8_BAR; }
    PG8_BAR;
#undef PG8_SA
#undef PG8_SB
#undef PG8_STAGE
#undef PG8_LDA
#undef PG8_LDB
#undef PG8_MMA
#undef PG8_WAIT_V
#undef PG8_WAIT_L
#undef PG8_BAR
#undef PG8_SCHED
}
}

namespace fx {
using pg8::bf16_t; using pg8::bf16x8; using pg8::f32x4; using pg8::u32x4; using pg8::u32x2; using pg8::Unit;
typedef float f32x16 __attribute__((ext_vector_type(16)));
typedef short s16x4 __attribute__((ext_vector_type(4)));
typedef short v4i16_t __attribute__((ext_vector_type(4)));
typedef float f32x2 __attribute__((ext_vector_type(2)));
typedef LAS unsigned char* ldsp;

constexpr int D = 1024, NB = 16, S = 4096, DEPTH = 4, INC = 7088;
constexpr int SLB = FX_SLB, T = SLB * S, NSL = NB / SLB;
constexpr int NP = 7168, YW = 3584;
constexpr float EPS = 1e-6f;
constexpr int O_UA = 0, O_VA = 512, O_ZA = 1024, O_CQ = 1536, O_CKV = 1792, O_KR = 1920, O_ZB = 1952, O_QC = 2464, O_KC = 2720, O_VC = 2976, O_GC = 3488, O_ZC = 3504, O_GATE = 4016;
constexpr int Y_UZ = 0, Y_GV = 512, Y_CQ = 1024, Y_CKV = 1280, Y_KR = 1408, Y_GC = 1440, Y_ZB = 1536, Y_QC = 2048, Y_KC = 2304, Y_VC = 2560, Y_ZC = 3072;
constexpr int LDS_BYTES = 155648;
constexpr int LDS_BARW = LDS_BYTES - 16;
constexpr float QSCALE = 0.10206207261596577f * 1.4426950408889634f;

struct P {
    const float* x_in; const int* pos; const float* norm_g; const float* w_in; const float* b_gate; const float* sg_ln_g; const float* sg_ln_b; const float* sg_w; const float* sg_b;
    const float* cq_g; const float* ckv_g; const float* w_uq; const float* w_ukv; const float* q_g; const float* k_g; const float* w_gate; const float* bg_gate; const float* o_g;
    const float* w_branch; const float* w_out; float* out;
    unsigned* bar; bf16_t* xb; float* rstd; float* ssq; bf16_t* Y; bf16_t* Q; bf16_t* K; bf16_t* V; bf16_t* UT; bf16_t* ST; float* dec; bf16_t* merged; u32x2* GT;
    bf16_t* Win_t; bf16_t* Wuq_t; bf16_t* Wukv_t; bf16_t* Wbr_t; bf16_t* Wout_t; bf16_t* sgw; float* cs; float* sn; bf16_t* wgp;
};

__device__ __forceinline__ unsigned pk2(float lo, float hi) { typedef __bf16 b2 __attribute__((ext_vector_type(2))); f32x2 v = {lo, hi}; b2 b = __builtin_convertvector(v, b2); return __builtin_bit_cast(unsigned, b); }
__device__ __forceinline__ float bflo(unsigned w) { return __uint_as_float(w << 16); }
__device__ __forceinline__ float bfhi(unsigned w) { return __uint_as_float(w & 0xffff0000u); }
__device__ __forceinline__ float bf1(bf16_t b) { return __uint_as_float((unsigned)b << 16); }
__device__ __forceinline__ bf16_t f2bf(float f) { return (bf16_t)(pk2(f, 0.f) & 0xffffu); }
__device__ __forceinline__ float t_exp2(float x) { return __builtin_amdgcn_exp2f(x); }
__device__ __forceinline__ float t_log2(float x) { return __builtin_amdgcn_logf(x); }
__device__ __forceinline__ float t_rcp(float x) { return __builtin_amdgcn_rcpf(x); }
__device__ __forceinline__ float t_rsq(float x) { return __builtin_amdgcn_rsqf(x); }
__device__ __forceinline__ float fsig(float b) { return t_rcp(1.0f + t_exp2(-1.4426950408889634f * b)); }
__device__ __forceinline__ float fgelu_arg(float x) { return x * __builtin_fmaf(x * x, -1.4426950408889634f * 1.5957691216057308f * 0.044715f, -1.4426950408889634f * 1.5957691216057308f); }
__device__ __forceinline__ float fgelu(float x) { return x * t_rcp(1.0f + t_exp2(fgelu_arg(x))); }
__device__ __forceinline__ float fsilu(float x) { return x * fsig(x); }
__device__ __forceinline__ float fexp(float x) { return t_exp2(1.4426950408889634f * x); }
__device__ __forceinline__ float flogsig(float a) { return fminf(a, 0.f) - 0.6931471805599453f * t_log2(1.0f + t_exp2(-1.4426950408889634f * fabsf(a))); }
#define MFMA16(a, b, c) __builtin_amdgcn_mfma_f32_16x16x32_bf16(a, b, c, 0, 0, 0)
#define MFMA32(a, b, c) __builtin_amdgcn_mfma_f32_32x32x16_bf16(a, b, c, 0, 0, 0)

__host__ __device__ __forceinline__ int insrc(int np) {
    const int pn = np >> 8, x = np & 255;
    if (pn < 4) return (x < 128 ? O_UA : O_ZA) + 128 * pn + (x & 127);
    if (pn < 6) return O_VA + 256 * (pn - 4) + x;
    if (pn == 6) return O_CQ + x;
    if (pn == 7) return x < 128 ? O_CKV + x : x < 160 ? O_KR + (x - 128) : x < 176 ? O_GC + (x - 160) : -1;
    if (pn < 10) return O_ZB + 256 * (pn - 8) + x;
    if (pn == 10) return O_QC + x;
    if (pn == 11) return O_KC + x;
    if (pn < 14) return O_VC + 256 * (pn - 12) + x;
    if (pn < 16) return O_ZC + 256 * (pn - 14) + x;
    return O_GATE + 256 * (pn - 16) + x;
}

struct EpiIn {
    static constexpr bool PERM = true, TWICE = (FX_TIME_PH == 21);
    bf16_t* Y; const float* rstd; const float* bgate; u32x2* GT;
    __device__ __forceinline__ void operator()(f32x4 (&acc)[2][2][4][2], const Unit& u, int wr, int wc, int fr, int fq) const {
        const int row0 = u.pm * 256 + wr * 64 + fr, pn = u.pn;
        float rs[2][4];
#pragma unroll
        for (int ai = 0; ai < 2; ++ai)
#pragma unroll
            for (int m = 0; m < 4; ++m) rs[ai][m] = rstd[row0 + ai * 128 + m * 16];
        if (pn < 4) {
#pragma unroll
            for (int ai = 0; ai < 2; ++ai)
#pragma unroll
                for (int m = 0; m < 4; ++m) {
                    const float r = rs[ai][m]; float o[8];
#pragma unroll
                    for (int n = 0; n < 2; ++n)
#pragma unroll
                        for (int j = 0; j < 4; ++j) { const float uu = acc[ai][0][m][n][j] * r, zz = acc[ai][1][m][n][j] * r;
                            o[n * 4 + j] = uu * zz * t_rcp((1.0f + t_exp2(fgelu_arg(uu))) * (1.0f + t_exp2(-1.4426950408889634f * zz))); }
                    u32x4 w; w.x = pk2(o[0], o[1]); w.y = pk2(o[2], o[3]); w.z = pk2(o[4], o[5]); w.w = pk2(o[6], o[7]);
                    *(u32x4*)(Y + (size_t)(row0 + ai * 128 + m * 16) * YW + Y_UZ + 128 * pn + 32 * wc + 8 * fq) = w;
                }
        } else {
            const int type = (pn < 6) ? 1 : (pn < 8) ? 0 : (pn < 10) ? 2 : (pn < 14) ? 0 : (pn < 16) ? 2 : 3;
            const int colb = 256 * pn - 512 + 32 * wc + 8 * fq;
            if (type == 3) {
                f32x4 bl[2][2];
#pragma unroll
                for (int bj = 0; bj < 2; ++bj)
#pragma unroll
                    for (int n = 0; n < 2; ++n) bl[bj][n] = *(const f32x4*)(bgate + 256 * (pn - 16) + 128 * bj + 32 * wc + 8 * fq + 4 * n) * (-1.4426950408889634f);
#pragma unroll
                for (int ai = 0; ai < 2; ++ai)
#pragma unroll
                    for (int m = 0; m < 4; ++m) {
                        const float rl = rs[ai][m] * (-1.4426950408889634f);
#pragma unroll
                        for (int bj = 0; bj < 2; ++bj) {
                            u32x2 g8; g8.x = 0u; g8.y = 0u;
#pragma unroll
                            for (int j = 0; j < 4; ++j) {
                                const float g0 = t_rcp(__builtin_fmaf(t_exp2(__builtin_fmaf(acc[ai][bj][m][0][j], rl, bl[bj][0][j])), 1.0f / 255.0f, 1.0f / 255.0f));
                                const float g1 = t_rcp(__builtin_fmaf(t_exp2(__builtin_fmaf(acc[ai][bj][m][1][j], rl, bl[bj][1][j])), 1.0f / 255.0f, 1.0f / 255.0f));
                                g8.x = __builtin_amdgcn_cvt_pk_u8_f32(g0, j, g8.x); g8.y = __builtin_amdgcn_cvt_pk_u8_f32(g1, j, g8.y); }
                            GT[((size_t)(u.pm * 12 + (pn - 16)) * 16 + (ai * 4 + m) * 2 + bj) * 512 + (wr * 4 + wc) * 64 + fq * 16 + fr] = g8;
                        }
                    }
            } else {
#pragma unroll
            for (int ai = 0; ai < 2; ++ai)
#pragma unroll
                for (int m = 0; m < 4; ++m) {
                    const float r = rs[ai][m];
#pragma unroll
                    for (int bj = 0; bj < 2; ++bj) {
                        float o[8];
#pragma unroll
                        for (int n = 0; n < 2; ++n)
#pragma unroll
                            for (int j = 0; j < 4; ++j) { const float v = acc[ai][bj][m][n][j] * r; o[n * 4 + j] = (type == 0) ? v : (type == 1) ? fgelu(v) : fsilu(v); }
                        u32x4 w; w.x = pk2(o[0], o[1]); w.y = pk2(o[2], o[3]); w.z = pk2(o[4], o[5]); w.w = pk2(o[6], o[7]);
                        *(u32x4*)(Y + (size_t)(row0 + ai * 128 + m * 16) * YW + colb + 128 * bj) = w;
                    }
                }
            }
        }
    }
};
struct EpiMerge {
    static constexpr bool PERM = true, TWICE = false;
    const u32x2* GT; bf16_t* merged;
    __device__ __forceinline__ void operator()(f32x4 (&acc)[2][2][4][2], const Unit& u, int wr, int wc, int fr, int fq) const {
        const int row0 = u.pm * 256 + wr * 64 + fr, br = u.br;
        const u32x2* gp = GT + ((size_t)(u.pm * 12 + br * 4 + u.pn) * 16) * 512 + (wr * 4 + wc) * 64; const int lo = (fq * 16 + fr) * 8;
        const __amdgpu_buffer_rsrc_t gr = __builtin_amdgcn_make_buffer_rsrc((void*)gp, 0, 1 << 20, 0x00020000);
#pragma unroll
        for (int ai = 0; ai < 2; ++ai) {
            u32x2 ga[8];
#pragma unroll
            for (int s8 = 0; s8 < 8; ++s8) ga[s8] = __builtin_bit_cast(u32x2, __builtin_amdgcn_raw_buffer_load_b64(gr, lo, (ai * 8 + s8) * 4096, 0));
            if (br < 2) {
                u32x2 gb[8];
#pragma unroll
                for (int s8 = 0; s8 < 8; ++s8) gb[s8] = __builtin_bit_cast(u32x2, __builtin_amdgcn_raw_buffer_load_b64(gr, lo, (64 + ai * 8 + s8) * 4096, 0));
                __builtin_amdgcn_sched_barrier(0);
#pragma unroll
                for (int m = 0; m < 4; ++m)
#pragma unroll
                    for (int bj = 0; bj < 2; ++bj) {
                        const u32x2 a = ga[m * 2 + bj], bq = gb[m * 2 + bj];
                        float f[8], h[8];
#pragma unroll
                        for (int j = 0; j < 4; ++j) { f[j] = (float)((a.x >> (8 * j)) & 255u); f[4 + j] = (float)((a.y >> (8 * j)) & 255u); h[j] = (float)((bq.x >> (8 * j)) & 255u); h[4 + j] = (float)((bq.y >> (8 * j)) & 255u); }
#pragma unroll
                        for (int j = 0; j < 8; ++j) f[j] = fmaxf(f[j], 255e-18f) * t_rcp(fmaxf(h[j], 255e-18f));
#pragma unroll
                        for (int n = 0; n < 2; ++n)
#pragma unroll
                            for (int j = 0; j < 4; ++j) acc[ai][bj][m][n][j] *= f[n * 4 + j];
                    }
            } else {
                __builtin_amdgcn_sched_barrier(0);
#pragma unroll
                for (int m = 0; m < 4; ++m) {
                    const int row = row0 + ai * 128 + m * 16;
#pragma unroll
                    for (int bj = 0; bj < 2; ++bj) {
                        const int col = u.pn * 256 + 128 * bj + 32 * wc + 8 * fq;
                        const u32x2 a = ga[m * 2 + bj];
                        float f[8], o[8];
#pragma unroll
                        for (int j = 0; j < 4; ++j) { f[j] = (float)((a.x >> (8 * j)) & 255u); f[4 + j] = (float)((a.y >> (8 * j)) & 255u); }
#pragma unroll
                        for (int n = 0; n < 2; ++n)
#pragma unroll
                            for (int j = 0; j < 4; ++j) o[n * 4 + j] = acc[ai][bj][m][n][j] * fmaxf(f[n * 4 + j] * (1.0f / 255.0f), 1e-18f);
                        u32x4 w; w.x = pk2(o[0], o[1]); w.y = pk2(o[2], o[3]); w.z = pk2(o[4], o[5]); w.w = pk2(o[6], o[7]);
                        *(u32x4*)(merged + (size_t)row * D + col) = w;
                    }
                }
            }
        }
    }
};
struct EpiOut {
    static constexpr bool PERM = true, TWICE = false;
    const float* xin; float* out; const bf16_t* xb; bf16_t* xbw; float* ssq; int first, last;
    template <bool FIRST, bool LAST, int MB> __device__ __forceinline__ void run(f32x4 (&acc)[2][2][4][2], const Unit& u, int wr, int wc, int fr, int fq) const {
        const int lo = fr * D + 8 * fq;
        const size_t ub = (size_t)(u.pm * 256 + wr * 64) * D + u.pn * 256 + 32 * wc;
#pragma unroll
        for (int ai = 0; ai < 2; ++ai)
#pragma unroll
            for (int m0 = 0; m0 < 4; m0 += MB) {
                f32x4 xa[MB][2][2]; u32x4 xw[MB][2];
#pragma unroll
                for (int mm = 0; mm < MB; ++mm)
#pragma unroll
                    for (int bj = 0; bj < 2; ++bj) {
                        const size_t o = ub + (size_t)(ai * 128 + (m0 + mm) * 16) * D + 128 * bj;
                        if (FIRST) { xa[mm][bj][0] = *(const f32x4*)(xin + o + lo); xa[mm][bj][1] = *(const f32x4*)(xin + o + lo + 4); }
                        else xw[mm][bj] = *(const u32x4*)(xb + o + lo);
                    }
                __builtin_amdgcn_sched_barrier(0);
#pragma unroll
                for (int mm = 0; mm < MB; ++mm) {
                    const int m = m0 + mm; float ss = 0.f;
#pragma unroll
                    for (int bj = 0; bj < 2; ++bj) {
                        const size_t o = ub + (size_t)(ai * 128 + m * 16) * D + 128 * bj;
                        float xr[8];
                        if (FIRST) { const f32x4 a = xa[mm][bj][0], b = xa[mm][bj][1]; xr[0] = a[0]; xr[1] = a[1]; xr[2] = a[2]; xr[3] = a[3]; xr[4] = b[0]; xr[5] = b[1]; xr[6] = b[2]; xr[7] = b[3]; }
                        else { const u32x4 w4 = xw[mm][bj]; xr[0] = bflo(w4.x); xr[1] = bfhi(w4.x); xr[2] = bflo(w4.y); xr[3] = bfhi(w4.y); xr[4] = bflo(w4.z); xr[5] = bfhi(w4.z); xr[6] = bflo(w4.w); xr[7] = bfhi(w4.w); }
                        float v[8];
#pragma unroll
                        for (int n = 0; n < 2; ++n)
#pragma unroll
                            for (int j = 0; j < 4; ++j) v[n * 4 + j] = xr[n * 4 + j] + acc[ai][bj][m][n][j];
                        if (LAST) { f32x4 va, vb; va[0] = v[0]; va[1] = v[1]; va[2] = v[2]; va[3] = v[3]; vb[0] = v[4]; vb[1] = v[5]; vb[2] = v[6]; vb[3] = v[7]; *(f32x4*)(out + o + lo) = va; *(f32x4*)(out + o + lo + 4) = vb; }
                        else {
#pragma unroll
                            for (int j = 0; j < 8; ++j) ss += v[j] * v[j];
                            u32x4 w; w.x = pk2(v[0], v[1]); w.y = pk2(v[2], v[3]); w.z = pk2(v[4], v[5]); w.w = pk2(v[6], v[7]); *(u32x4*)(xbw + o + lo) = w; }
                    }
                    if (!LAST) { ss += __shfl_xor(ss, 16); ss += __shfl_xor(ss, 32); if (fq == 0) ssq[((size_t)(u.pm * 256 + wr * 64 + fr + ai * 128 + m * 16) * 4 + u.pn) * 32 + wc] = ss; }
                }
            }
    }
    __device__ __forceinline__ void operator()(f32x4 (&acc)[2][2][4][2], const Unit& u, int wr, int wc, int fr, int fq) const {
        if (first) run<true, false, 2>(acc, u, wr, wc, fr, fq);
        else if (last) run<false, true, 4>(acc, u, wr, wc, fr, fq);
        else run<false, false, 4>(acc, u, wr, wc, fr, fq);
    }
};

template <int MODE> __device__ __forceinline__ void conv_wt(const float* src, int ldn, int K, bf16_t* dst, int Np, const float* gk, ldsp lds, int tid, int& toff) {
    const int tn = Np >> 7, tk = K >> 6, ntile = tn * tk;
    LAS bf16_t* Tt = (LAS bf16_t*)lds;
    const int kr = tid >> 3, c8 = (tid & 7) * 8;
    f32x4 v[2][2]; float gsc;
#define CW_LOAD(tile_) do { const int n0_ = ((tile_) % tn) * 128, k0_ = ((tile_) / tn) * 64; \
    _Pragma("unroll") \
        for (int hh = 0; hh < 2; ++hh) { const int col_ = (MODE == 0) ? insrc(n0_ + 64 * hh + c8) : n0_ + 64 * hh + c8; \
            v[hh][0] = (f32x4){0.f, 0.f, 0.f, 0.f}; v[hh][1] = v[hh][0]; \
            if (col_ >= 0) { const float* sp_ = src + (size_t)(k0_ + kr) * ldn + col_; v[hh][0] = *(const f32x4*)sp_; v[hh][1] = *(const f32x4*)(sp_ + 4); } } \
        gsc = gk ? gk[k0_ + kr] : 1.0f; } while (0)
    int tile = (int)((blockIdx.x + gridDim.x - (unsigned)toff % gridDim.x) % gridDim.x); toff += ntile;
    if (tile < ntile) CW_LOAD(tile);
    for (; tile < ntile; tile += gridDim.x) {
        const int n0 = (tile % tn) * 128, k0 = (tile / tn) * 64;
#pragma unroll
        for (int hh = 0; hh < 2; ++hh)
#pragma unroll
            for (int j = 0; j < 4; ++j) { Tt[(64 * hh + c8 + j) * 72 + kr] = f2bf(v[hh][0][j] * gsc); Tt[(64 * hh + c8 + 4 + j) * 72 + kr] = f2bf(v[hh][1][j] * gsc); }
        __syncthreads();
        if (tile + (int)gridDim.x < ntile) CW_LOAD(tile + (int)gridDim.x);
#pragma unroll
        for (int hh = 0; hh < 2; ++hh) { const int n = 64 * hh + (tid >> 3), kc = (tid & 7) * 8; *(u32x4*)(dst + (size_t)(n0 + n) * K + k0 + kc) = *(const LAS u32x4*)(Tt + n * 72 + kc); }
        __syncthreads();
    }
#undef CW_LOAD
}
__device__ __forceinline__ void p0_prologue(const P& p, ldsp lds) {
    int tid = threadIdx.x; asm volatile("" : "+v"(tid));
    const int gtid = blockIdx.x * 512 + tid, gth = gridDim.x * 512;
    int toff = 0;
    for (int l = 0; l < DEPTH; ++l) {
        conv_wt<0>(p.w_in + (size_t)l * D * INC, INC, D, p.Win_t + (size_t)l * NP * D, NP, p.norm_g + l * D, lds, tid, toff);
        conv_wt<1>(p.w_uq + (size_t)l * 256 * 768, 768, 256, p.Wuq_t + (size_t)l * 768 * 256, 768, p.cq_g + l * 256, lds, tid, toff);
        conv_wt<1>(p.w_ukv + (size_t)l * 128 * 1024, 1024, 128, p.Wukv_t + (size_t)l * 1024 * 128, 1024, p.ckv_g + l * 128, lds, tid, toff);
        for (int i = 0; i < 3; ++i) conv_wt<1>(p.w_branch + ((size_t)l * 3 + i) * 512 * D, D, 512, p.Wbr_t + ((size_t)l * 3 + i) * D * 512, D, nullptr, lds, tid, toff);
        conv_wt<1>(p.w_out + (size_t)l * D * D, D, D, p.Wout_t + (size_t)l * D * D, D, nullptr, lds, tid, toff);
    }
    for (int i = gtid; i < DEPTH * 4 * 128 * 128; i += gth) { const int j = i & 127, ii = (i >> 7) & 127; p.sgw[i] = ((ii >> 6) >= (j >> 6)) ? f2bf(p.sg_w[i]) : (bf16_t)0; }
    for (int i = gtid; i < DEPTH * 256 * 8; i += gth) { const int q = i & 7, hd = (i >> 3) & 255, ll = i >> 11;
        const float w0 = p.w_gate[((size_t)ll * 16 + 2 * q) * 256 + hd], w1 = p.w_gate[((size_t)ll * 16 + 2 * q + 1) * 256 + hd];
        const unsigned hi = pk2(w0, w1), lo = pk2(w0 - bflo(hi), w1 - bfhi(hi));
        ((unsigned*)p.wgp)[((size_t)ll * 256 + hd) * 16 + q] = hi; ((unsigned*)p.wgp)[((size_t)ll * 256 + hd) * 16 + 8 + q] = lo; }
    for (int i = gtid; i < NB * S * 16; i += gth) { const int t = i >> 4, f = i & 15; const double inv = exp(-(double)f * (2.0 / 32.0) * log(10000.0)); const double ang = (double)p.pos[t] * inv; p.cs[i] = (float)cos(ang); p.sn[i] = (float)sin(ang); }
    const int lane = tid & 63, gw = gtid >> 6, nw = gth >> 6;
    for (int row0 = gw * 4; row0 < NB * S; row0 += nw * 4) {
        f32x4 v[4][4];
#pragma unroll
        for (int r = 0; r < 4; ++r)
#pragma unroll
            for (int j = 0; j < 4; ++j) v[r][j] = *(const f32x4*)(p.x_in + (size_t)(row0 + r) * D + j * 256 + lane * 4);
        __builtin_amdgcn_sched_barrier(0);
#pragma unroll
        for (int r = 0; r < 4; ++r) { float ss = 0.f;
#pragma unroll
            for (int j = 0; j < 4; ++j) { ss += (v[r][j][0] * v[r][j][0] + v[r][j][1] * v[r][j][1]) + (v[r][j][2] * v[r][j][2] + v[r][j][3] * v[r][j][3]);
                u32x2 w; w.x = pk2(v[r][j][0], v[r][j][1]); w.y = pk2(v[r][j][2], v[r][j][3]); *(u32x2*)(p.xb + (size_t)(row0 + r) * D + j * 256 + lane * 4) = w; }
#pragma unroll
            for (int o = 32; o > 0; o >>= 1) ss += __shfl_xor(ss, o);
            if (lane == 0) p.rstd[row0 + r] = t_rsq(ss * (1.0f / D) + EPS); }
    }
}
__device__ __forceinline__ void p8_rstd(const P& p, int ps) {
    int tid = threadIdx.x; asm volatile("" : "+v"(tid));
    for (int row = ps * T + blockIdx.x * 512 + tid; row < (ps + 1) * T; row += gridDim.x * 512) {
        f32x4 a[4];
#pragma unroll
        for (int t4 = 0; t4 < 4; ++t4) a[t4] = *(const f32x4*)(p.ssq + ((size_t)row * 4 + t4) * 32);
        __builtin_amdgcn_sched_barrier(0);
        float s = 0.f;
#pragma unroll
        for (int t4 = 0; t4 < 4; ++t4) s += (a[t4][0] + a[t4][1]) + (a[t4][2] + a[t4][3]);
        p.rstd[row] = t_rsq(s * (1.0f / D) + EPS);
    }
}

constexpr int M2_A = 0, M2_B = 51200, M2_G = 51200 + 35840, M2_END = M2_G + 768;
constexpr int M2_AROW = 528, M2_ASEG = 16 * 528 + 64, M2_BROW = 272, M2_BSEG = 16 * 272 + 64;
static_assert(M2_END <= LDS_BARW, "MLA (128-token form) LDS map");
__device__ __forceinline__ void mla_units128(const P& p, int l, int sl, int ubeg, int ustep, int uend, ldsp lds) {
    int tid = threadIdx.x; asm volatile("" : "+v"(tid) :: "memory");
    const int lane = tid & 63, fr = lane & 15, g = lane >> 4; const int w = __builtin_amdgcn_readfirstlane(tid >> 6);
    const bf16_t* Wq = p.Wuq_t + (size_t)l * 768 * 256; const bf16_t* Wkv = p.Wukv_t + (size_t)l * 1024 * 128;
    int offA[7], offB[5];
#pragma unroll
    for (int i_ = 0; i_ < 7; ++i_) { const int j_ = min(w + 8 * i_, 49); const int pc_ = j_ * 64 + lane; const int sg_ = pc_ / 532, q_ = min(pc_ % 532, 527); const int row_ = min(sg_ * 16 + q_ / 33, 95), c_ = min(q_ % 33, 31); offA[i_] = (row_ * 256 + c_ * 8) * 2; }
#pragma unroll
    for (int i_ = 0; i_ < 5; ++i_) { const int j_ = min(w + 8 * i_, 34); const int pc_ = j_ * 64 + lane; const int sg_ = pc_ / 276, q_ = min(pc_ % 276, 271); const int row_ = min(sg_ * 16 + q_ / 17, 127), c_ = min(q_ % 17, 15); offB[i_] = (row_ * 128 + c_ * 8) * 2; }
#define M2_DMA_A(h_) do { const char* src_ = (const char*)(Wq + (size_t)(h_) * 96 * 256); \
    _Pragma("unroll") \
        for (int i_ = 0; i_ < 7; ++i_) __builtin_amdgcn_global_load_lds((const unsigned*)(src_ + offA[i_]), (LAS unsigned*)(lds + M2_A + min(w + 8 * i_, 49) * 1024), 16, 0, 0); } while (0)
#define M2_DMA_B(h_) do { const char* src_ = (const char*)(Wkv + (size_t)(h_) * 128 * 128); \
    _Pragma("unroll") \
        for (int i_ = 0; i_ < 5; ++i_) __builtin_amdgcn_global_load_lds((const unsigned*)(src_ + offB[i_]), (LAS unsigned*)(lds + M2_B + min(w + 8 * i_, 34) * 1024), 16, 0, 0); } while (0)
#define M2_BAR() asm volatile("s_waitcnt lgkmcnt(0)\n\ts_barrier" ::: "memory")
    for (int un = ubeg; un < uend; un += ustep) {
        const int r0 = un * 128, bl = r0 / S, s0 = r0 % S, tk = 16 * w + fr;
        const size_t tokg = (size_t)sl * T + r0;
        M2_DMA_A(0); M2_DMA_B(0);
        const int pl = 8 * (fr >> 2) + (fr & 3);
        const int oa0 = (pl >> 4) * M2_ASEG + (pl & 15) * M2_AROW + g * 16, oa1 = ((pl + 4) >> 4) * M2_ASEG + ((pl + 4) & 15) * M2_AROW + g * 16, oar = fr * M2_AROW + g * 16;
        const int ob0 = (pl >> 4) * M2_BSEG + (pl & 15) * M2_BROW + g * 16, ob1 = ((pl + 4) >> 4) * M2_BSEG + ((pl + 4) & 15) * M2_BROW + g * 16;
        const bf16_t* yr = p.Y + (size_t)(r0 + tk) * YW;
        bf16x8 xq[8], xkv[4];
#pragma unroll
        for (int ks = 0; ks < 8; ++ks) xq[ks] = *(const bf16x8*)(yr + Y_CQ + 32 * ks + 8 * g);
#pragma unroll
        for (int ks = 0; ks < 4; ++ks) xkv[ks] = *(const bf16x8*)(yr + Y_CKV + 32 * ks + 8 * g);
        const u32x2 kra = *(const u32x2*)(yr + Y_KR + 4 * g), krb = *(const u32x2*)(yr + Y_KR + 16 + 4 * g);
        const f32x4 c4 = *(const f32x4*)(p.cs + (tokg + tk) * 16 + 4 * g), s4 = *(const f32x4*)(p.sn + (tokg + tk) * 16 + 4 * g);
        if (tid < 24) *(LAS f32x4*)(lds + M2_G + tid * 16) = *(const f32x4*)(p.q_g + l * 96 + 4 * tid);
        else if (tid >= 32 && tid < 56) *(LAS f32x4*)(lds + M2_G + 384 + (tid - 32) * 16) = *(const f32x4*)(p.k_g + l * 96 + 4 * (tid - 32));
        float sq_ = 0.f, sk_ = 0.f;
#pragma unroll
        for (int ks = 0; ks < 8; ++ks)
#pragma unroll
            for (int j = 0; j < 8; ++j) { const float v = bf1((bf16_t)xq[ks][j]); sq_ += v * v; }
#pragma unroll
        for (int ks = 0; ks < 4; ++ks)
#pragma unroll
            for (int j = 0; j < 8; ++j) { const float v = bf1((bf16_t)xkv[ks][j]); sk_ += v * v; }
        sq_ += __shfl_xor(sq_, 16); sq_ += __shfl_xor(sq_, 32); sk_ += __shfl_xor(sk_, 16); sk_ += __shfl_xor(sk_, 32);
        const float r1q = t_rsq(sq_ * (1.0f / 256.0f) + EPS), r1k = t_rsq(sk_ * (1.0f / 128.0f) + EPS);
        const float k1[4] = {bflo(kra.x), bfhi(kra.x), bflo(kra.y), bfhi(kra.y)}, k2[4] = {bflo(krb.x), bfhi(krb.x), bflo(krb.y), bfhi(krb.y)};
        asm volatile("s_waitcnt vmcnt(0)" ::: "memory");
        M2_BAR();
        for (int h = 0; h < 8; ++h) {
            bf16_t* qo = p.Q + ((size_t)(bl * 8 + h) * S + s0 + tk) * 96 + 4 * g; bf16_t* ko = p.K + ((size_t)(bl * 8 + h) * S + s0 + tk) * 96 + 4 * g;
            bf16_t* qo8 = qo + 4 * g; bf16_t* ko8 = ko + 4 * g; bf16_t* vo8 = p.V + ((size_t)(bl * 8 + h) * S + s0 + tk) * 64 + 8 * g;
            if (h > 0) { asm volatile("s_waitcnt vmcnt(14)" ::: "memory"); M2_BAR(); }
            f32x4 acc[6];
#pragma unroll
            for (int mt = 0; mt < 6; ++mt) acc[mt] = (f32x4){0.f, 0.f, 0.f, 0.f};
#pragma unroll
            for (int ks = 0; ks < 8; ++ks) {
                bf16x8 a[6];
#pragma unroll
                for (int mt = 0; mt < 6; ++mt) a[mt] = *(const LAS bf16x8*)(lds + M2_A + (mt < 4 ? 2 * (mt >> 1) * M2_ASEG + ((mt & 1) ? oa1 : oa0) : mt * M2_ASEG + oar) + ks * 64);
#pragma unroll
                for (int mt = 0; mt < 6; ++mt) acc[mt] = MFMA16(a[mt], xq[ks], acc[mt]);
            }
            M2_BAR();
            if (h < 7) M2_DMA_A(h + 1);
            {
                f32x4 qg[6];
#pragma unroll
                for (int mt = 0; mt < 6; ++mt) qg[mt] = *(const LAS f32x4*)(lds + M2_G + (mt < 4 ? 32 * (mt >> 1) + 8 * g + 4 * (mt & 1) : 16 * mt + 4 * g) * 4);
                float sqn = 0.f;
#pragma unroll
                for (int mt = 0; mt < 6; ++mt) sqn += (acc[mt][0] * acc[mt][0] + acc[mt][1] * acc[mt][1]) + (acc[mt][2] * acc[mt][2] + acc[mt][3] * acc[mt][3]);
                sqn += __shfl_xor(sqn, 16); sqn += __shfl_xor(sqn, 32);
                const float rq = t_rsq(sqn * (r1q * r1q * (1.0f / 96.0f)) + EPS) * (r1q * QSCALE);
#pragma unroll
                for (int a2 = 0; a2 < 2; ++a2) { u32x4 o;
                    o.x = pk2(acc[2 * a2][0] * rq * qg[2 * a2][0], acc[2 * a2][1] * rq * qg[2 * a2][1]); o.y = pk2(acc[2 * a2][2] * rq * qg[2 * a2][2], acc[2 * a2][3] * rq * qg[2 * a2][3]);
                    o.z = pk2(acc[2 * a2 + 1][0] * rq * qg[2 * a2 + 1][0], acc[2 * a2 + 1][1] * rq * qg[2 * a2 + 1][1]); o.w = pk2(acc[2 * a2 + 1][2] * rq * qg[2 * a2 + 1][2], acc[2 * a2 + 1][3] * rq * qg[2 * a2 + 1][3]);
                    *(u32x4*)(qo8 + 32 * a2) = o; }
                float o1[4], o2[4];
#pragma unroll
                for (int j = 0; j < 4; ++j) { const float x1 = acc[4][j] * rq * qg[4][j], x2 = acc[5][j] * rq * qg[5][j]; o1[j] = x1 * c4[j] - x2 * s4[j]; o2[j] = x1 * s4[j] + x2 * c4[j]; }
                u32x2 w1, w2; w1.x = pk2(o1[0], o1[1]); w1.y = pk2(o1[2], o1[3]); w2.x = pk2(o2[0], o2[1]); w2.y = pk2(o2[2], o2[3]);
                *(u32x2*)(qo + 64) = w1; *(u32x2*)(qo + 80) = w2;
            }
            if (h < 7) asm volatile("s_waitcnt vmcnt(16)" ::: "memory");
            else asm volatile("s_waitcnt vmcnt(9)" ::: "memory");
            M2_BAR();
            f32x4 ac2[8];
#pragma unroll
            for (int m = 0; m < 8; ++m) ac2[m] = (f32x4){0.f, 0.f, 0.f, 0.f};
#pragma unroll
            for (int ks = 0; ks < 4; ++ks) {
                bf16x8 b[8];
#pragma unroll
                for (int m = 0; m < 8; ++m) b[m] = *(const LAS bf16x8*)(lds + M2_B + 2 * (m >> 1) * M2_BSEG + ((m & 1) ? ob1 : ob0) + ks * 64);
#pragma unroll
                for (int m = 0; m < 8; ++m) ac2[m] = MFMA16(b[m], xkv[ks], ac2[m]);
            }
            M2_BAR();
            if (h < 7) M2_DMA_B(h + 1);
            {
                f32x4 kg[6];
#pragma unroll
                for (int mt = 0; mt < 6; ++mt) kg[mt] = *(const LAS f32x4*)(lds + M2_G + 384 + (mt < 4 ? 32 * (mt >> 1) + 8 * g + 4 * (mt & 1) : 16 * mt + 4 * g) * 4);
                float skn = 0.f;
#pragma unroll
                for (int mt = 0; mt < 4; ++mt) skn += (ac2[mt][0] * ac2[mt][0] + ac2[mt][1] * ac2[mt][1]) + (ac2[mt][2] * ac2[mt][2] + ac2[mt][3] * ac2[mt][3]);
                skn *= r1k * r1k;
#pragma unroll
                for (int j = 0; j < 4; ++j) skn += k1[j] * k1[j] + k2[j] * k2[j];
                skn += __shfl_xor(skn, 16); skn += __shfl_xor(skn, 32);
                const float rk = t_rsq(skn * (1.0f / 96.0f) + EPS), rkn = rk * r1k;
#pragma unroll
                for (int a2 = 0; a2 < 2; ++a2) { u32x4 o;
                    o.x = pk2(ac2[2 * a2][0] * rkn * kg[2 * a2][0], ac2[2 * a2][1] * rkn * kg[2 * a2][1]); o.y = pk2(ac2[2 * a2][2] * rkn * kg[2 * a2][2], ac2[2 * a2][3] * rkn * kg[2 * a2][3]);
                    o.z = pk2(ac2[2 * a2 + 1][0] * rkn * kg[2 * a2 + 1][0], ac2[2 * a2 + 1][1] * rkn * kg[2 * a2 + 1][1]); o.w = pk2(ac2[2 * a2 + 1][2] * rkn * kg[2 * a2 + 1][2], ac2[2 * a2 + 1][3] * rkn * kg[2 * a2 + 1][3]);
                    *(u32x4*)(ko8 + 32 * a2) = o; }
                float o1[4], o2[4];
#pragma unroll
                for (int j = 0; j < 4; ++j) { const float x1 = k1[j] * rk * kg[4][j], x2 = k2[j] * rk * kg[5][j]; o1[j] = x1 * c4[j] - x2 * s4[j]; o2[j] = x1 * s4[j] + x2 * c4[j]; }
                u32x2 w1, w2; w1.x = pk2(o1[0], o1[1]); w1.y = pk2(o1[2], o1[3]); w2.x = pk2(o2[0], o2[1]); w2.y = pk2(o2[2], o2[3]);
                *(u32x2*)(ko + 64) = w1; *(u32x2*)(ko + 80) = w2;
#pragma unroll
                for (int a2 = 0; a2 < 2; ++a2) { const f32x4 v0 = ac2[4 + 2 * a2] * r1k, v1 = ac2[5 + 2 * a2] * r1k; u32x4 o; o.x = pk2(v0[0], v0[1]); o.y = pk2(v0[2], v0[3]); o.z = pk2(v1[0], v1[1]); o.w = pk2(v1[2], v1[3]); *(u32x4*)(vo8 + 32 * a2) = o; }
            }
        }
        asm volatile("s_waitcnt vmcnt(0)" ::: "memory");
        M2_BAR();
    }
#undef M2_DMA_A
#undef M2_DMA_B
#undef M2_BAR
}

constexpr int GL_BC = 0, GL_VT = 0, GL_QT = 73728, GL_KT = 107520, GL_G = 141312, GL_END = 145408;
static_assert(GL_END <= LDS_BARW, "GLA LDS map");
__device__ __forceinline__ void gla_cumsum(const P& p, int l, int r0, ldsp lds, int tid) {
    LAS float* Bc = (LAS float*)(lds + GL_BC);
    const int lane = tid & 63, fr = lane & 15, g = lane >> 4; const int w = __builtin_amdgcn_readfirstlane(tid >> 6);
    bf16x8 ag[4];
#pragma unroll
    for (int mt = 0; mt < 4; ++mt) ag[mt] = *(const bf16x8*)(p.Y + (size_t)(r0 + 16 * mt + fr) * YW + Y_GC + 8 * (g & 1));
    bf16x8 bw[2]; float bias[2];
#pragma unroll
    for (int nt = 0; nt < 2; ++nt) {
        const int hd = 32 * w + 16 * nt + fr;
        bias[nt] = p.bg_gate[l * 256 + hd];
        bw[nt] = *(const bf16x8*)(p.wgp + ((size_t)l * 256 + hd) * 32 + 8 * g);
    }
    float run[2] = {0.f, 0.f};
#pragma unroll
    for (int mt = 0; mt < 4; ++mt)
#pragma unroll
        for (int nt = 0; nt < 2; ++nt) {
            const f32x4 c = MFMA16(ag[mt], bw[nt], ((f32x4){0.f, 0.f, 0.f, 0.f}));
            const float p0 = flogsig(c[0] + bias[nt]) * (1.0f / 16.0f), p1 = p0 + flogsig(c[1] + bias[nt]) * (1.0f / 16.0f), p2 = p1 + flogsig(c[2] + bias[nt]) * (1.0f / 16.0f), p3 = p2 + flogsig(c[3] + bias[nt]) * (1.0f / 16.0f);
            const float u1 = __shfl(p3, (lane - 16) & 63); const float s1 = p3 + (g >= 1 ? u1 : 0.f);
            const float u2 = __shfl(s1, (lane - 32) & 63); const float s2 = s1 + (g >= 2 ? u2 : 0.f);
            const float tot = __shfl(s2, fr + 48);
            const float base = run[nt] + (s2 - p3);
            LAS float* bo = Bc + (16 * mt + 4 * g) * 256 + 32 * w + 16 * nt + fr;
            bo[0] = base + p0; bo[256] = base + p1; bo[512] = base + p2; bo[768] = base + p3;
            run[nt] += tot;
        }
    __syncthreads();
}
constexpr int GL_VS = 1056;
static_assert(64 * GL_VS <= GL_QT, "GLA V image");
__device__ __forceinline__ void gla_req_v(const P& p, int r0, int tid, u32x4 (&v)[8]) {
#pragma unroll
    for (int i = 0; i < 8; ++i) { const int pc = tid + 512 * i; v[i] = *(const u32x4*)(p.Y + (size_t)(r0 + (pc >> 6)) * YW + Y_VC + 8 * (pc & 63)); }
}
__device__ __forceinline__ void gla_put_v(ldsp lds, int tid, const u32x4 (&v)[8]) {
#pragma unroll
    for (int i = 0; i < 8; ++i) { const int pc = tid + 512 * i; *(LAS u32x4*)(lds + GL_VT + (pc >> 6) * GL_VS + (pc & 63) * 16) = v[i]; }
}
template <int BASE = GL_VT, int STR = GL_VS, int CS = 4> __device__ __forceinline__ bf16x8 gla_vfrag(ldsp lds, int e0, int ks, int lane) {
    const int g = lane >> 4, q = (lane & 15) >> 2, pp = lane & 3;
    const ldsp a = lds + BASE + (32 * ks + 8 * g + q) * STR + (e0 + CS * pp) * 2;
    const s16x4 x0 = __builtin_bit_cast(s16x4, __builtin_amdgcn_ds_read_tr16_b64_v4i16((LAS v4i16_t*)a));
    const s16x4 x1 = __builtin_bit_cast(s16x4, __builtin_amdgcn_ds_read_tr16_b64_v4i16((LAS v4i16_t*)(a + 4 * STR)));
    return (bf16x8){x0[0], x0[1], x0[2], x0[3], x1[0], x1[1], x1[2], x1[3]};
}
constexpr int GL_KS = 544;
static_assert(GL_QT + 64 * GL_KS <= GL_G, "GLA pass A K image");
__device__ __forceinline__ void gla_a_unit(const P& p, int l, int un, ldsp lds) {
    int tid = threadIdx.x; asm volatile("" : "+v"(tid) :: "memory");
    const int lane = tid & 63, fr = lane & 15, g = lane >> 4; const int w = __builtin_amdgcn_readfirstlane(tid >> 6);
    const int r0 = un * 64, bl = r0 / S, n = (r0 % S) >> 6;
    u32x4 kv[4], vv[8];
    { const bf16_t* ks_ = p.Y + (size_t)(r0 + (tid >> 3)) * YW + Y_KC + 8 * (tid & 7);
#pragma unroll
      for (int j = 0; j < 4; ++j) kv[j] = *(const u32x4*)(ks_ + 64 * j); }
    gla_req_v(p, r0, tid, vv);
    __builtin_amdgcn_sched_barrier(0);
    gla_cumsum(p, l, r0, lds, tid);
    LAS float* Bc = (LAS float*)(lds + GL_BC);
    {
        const int t = tid >> 3, c = tid & 7;
#pragma unroll
        for (int j = 0; j < 4; ++j) {
            const LAS f32x4* bp = (const LAS f32x4*)(Bc + t * 256 + 64 * j + 8 * c); const LAS f32x4* lp = (const LAS f32x4*)(Bc + 63 * 256 + 64 * j + 8 * c);
            const f32x4 b0 = bp[0], b1 = bp[1], l0 = lp[0], l1 = lp[1];
            const float dd[8] = {l0[0] - b0[0], l0[1] - b0[1], l0[2] - b0[2], l0[3] - b0[3], l1[0] - b1[0], l1[1] - b1[1], l1[2] - b1[2], l1[3] - b1[3]};
            const unsigned kw[4] = {kv[j].x, kv[j].y, kv[j].z, kv[j].w}; unsigned ko[4];
#pragma unroll
            for (int e2 = 0; e2 < 4; ++e2) ko[e2] = pk2(bflo(kw[e2]) * fexp(dd[2 * e2]), bfhi(kw[e2]) * fexp(dd[2 * e2 + 1]));
            *(LAS u32x4*)(lds + GL_QT + t * GL_KS + (64 * j + 8 * c) * 2) = (u32x4){ko[0], ko[1], ko[2], ko[3]};
        }
        if (tid < 256) p.dec[((size_t)(bl * 4 + (tid >> 6)) * 64 + n) * 64 + (tid & 63)] = fexp(Bc[63 * 256 + tid]);
    }
    __syncthreads();
    gla_put_v(lds, tid, vv);
    __syncthreads();
    const int h = w >> 1, eh = w & 1;
    f32x4 acc[4][4];
#pragma unroll
    for (int a = 0; a < 4; ++a)
#pragma unroll
        for (int b = 0; b < 4; ++b) acc[a][b] = (f32x4){0.f, 0.f, 0.f, 0.f};
#pragma unroll
    for (int ks = 0; ks < 2; ++ks) {
        bf16x8 af[4], bf[4];
#pragma unroll
        for (int md = 0; md < 4; ++md) af[md] = gla_vfrag<GL_QT, GL_KS, 8>(lds, h * 64 + 32 * (md >> 1) + 4 * (md & 1), ks, lane);
#pragma unroll
        for (int ne = 0; ne < 4; ++ne) bf[ne] = gla_vfrag(lds, h * 128 + 64 * eh + 16 * ne, ks, lane);
#pragma unroll
        for (int md = 0; md < 4; ++md)
#pragma unroll
            for (int ne = 0; ne < 4; ++ne) acc[md][ne] = MFMA16(af[md], bf[ne], acc[md][ne]);
    }
    bf16_t* U = p.UT + ((size_t)(bl * 4 + h) * 64 + n) * 8192;
#pragma unroll
    for (int a2 = 0; a2 < 2; ++a2)
#pragma unroll
        for (int ne = 0; ne < 4; ++ne) { const f32x4 c0 = acc[2 * a2][ne], c1 = acc[2 * a2 + 1][ne]; u32x4 o; o.x = pk2(c0[0], c0[1]); o.y = pk2(c0[2], c0[3]); o.z = pk2(c1[0], c1[1]); o.w = pk2(c1[2], c1[3]);
            *(u32x4*)(U + (size_t)(64 * eh + 16 * ne + fr) * 64 + 32 * a2 + 8 * g) = o; }
    __syncthreads();
}
__device__ __forceinline__ void gla_scan(const P& p) {
    int tid = threadIdx.x; asm volatile("" : "+v"(tid));
    if (tid >= 128) return;
    for (size_t i = (size_t)blockIdx.x * 1024 + tid * 8; i < (size_t)SLB * 4 * 8192; i += (size_t)gridDim.x * 1024) {
        const size_t bh4 = i >> 13, ed = i & 8191; const int d = (int)(ed & 63);
        float st[8];
#pragma unroll
        for (int j = 0; j < 8; ++j) st[j] = 0.f;
        u32x4 ua[4], ub[4]; f32x4 da[4][2], db[4][2];
#define SC_LOAD(U, DC, n0) do { _Pragma("unroll") for (int k = 0; k < 4; ++k) { const size_t o_ = (bh4 * 64 + (n0) + k) * 8192 + ed; U[k] = *(const u32x4*)(p.UT + o_); \
            const float* dp_ = p.dec + (bh4 * 64 + (n0) + k) * 64 + d; DC[k][0] = *(const f32x4*)dp_; DC[k][1] = *(const f32x4*)(dp_ + 4); } } while (0)
#define SC_APPLY(U, DC, n0) do { _Pragma("unroll") for (int k = 0; k < 4; ++k) { const size_t o_ = (bh4 * 64 + (n0) + k) * 8192 + ed; \
            u32x4 w_; w_.x = pk2(st[0], st[1]); w_.y = pk2(st[2], st[3]); w_.z = pk2(st[4], st[5]); w_.w = pk2(st[6], st[7]); *(u32x4*)(p.ST + o_) = w_;     \
            const unsigned uu_[4] = {U[k].x, U[k].y, U[k].z, U[k].w}; \
            _Pragma("unroll") for (int q = 0; q < 4; ++q) { st[2 * q] = DC[k][q >> 1][(2 * q) & 3] * st[2 * q] + bflo(uu_[q]); st[2 * q + 1] = DC[k][q >> 1][(2 * q + 1) & 3] * st[2 * q + 1] + bfhi(uu_[q]); } } } while (0)
        SC_LOAD(ua, da, 0);
        for (int nb = 0; nb < 64; nb += 8) {
            SC_LOAD(ub, db, nb + 4);
            __builtin_amdgcn_sched_barrier(0);
            SC_APPLY(ua, da, nb);
            if (nb + 8 < 64) SC_LOAD(ua, da, nb + 8);
            __builtin_amdgcn_sched_barrier(0);
            SC_APPLY(ub, db, nb + 4);
        }
#undef SC_LOAD
#undef SC_APPLY
    }
}
__device__ __forceinline__ void gla_b_unit(const P& p, int l, int un, ldsp lds, bool DRY) {
    int tid = threadIdx.x; asm volatile("" : "+v"(tid) :: "memory");
    const int lane = tid & 63, fr = lane & 15, g = lane >> 4; const int w = __builtin_amdgcn_readfirstlane(tid >> 6);
    const int r0 = un * 64, bl = r0 / S, n = (r0 % S) >> 6;
    u32x4 qv[4], kv[4], vv[8];
    { const bf16_t* qs = p.Y + (size_t)(r0 + (tid >> 3)) * YW + Y_QC + 8 * (tid & 7); const bf16_t* ks = p.Y + (size_t)(r0 + (tid >> 3)) * YW + Y_KC + 8 * (tid & 7);
#pragma unroll
      for (int j = 0; j < 4; ++j) { qv[j] = *(const u32x4*)(qs + 64 * j); kv[j] = *(const u32x4*)(ks + 64 * j); } }
    gla_req_v(p, r0, tid, vv);
    __builtin_amdgcn_sched_barrier(0);
    gla_cumsum(p, l, r0, lds, tid);
    LAS float* Bc = (LAS float*)(lds + GL_BC);
    {
        const int t = tid >> 3, c = tid & 7; LAS bf16_t* QT = (LAS bf16_t*)(lds + GL_QT); LAS bf16_t* KT = (LAS bf16_t*)(lds + GL_KT);
#pragma unroll
        for (int j = 0; j < 4; ++j) {
            const LAS f32x4* bp = (const LAS f32x4*)(Bc + t * 256 + 64 * j + 8 * c); const f32x4 b0 = bp[0], b1 = bp[1];
            const float bb[8] = {b0[0], b0[1], b0[2], b0[3], b1[0], b1[1], b1[2], b1[3]};
            const unsigned qw[4] = {qv[j].x, qv[j].y, qv[j].z, qv[j].w}, kw[4] = {kv[j].x, kv[j].y, kv[j].z, kv[j].w};
            unsigned qo[4], ko[4];
#pragma unroll
            for (int e2 = 0; e2 < 4; ++e2) {
                qo[e2] = pk2(bflo(qw[e2]) * 0.125f * fexp(bb[2 * e2]), bfhi(qw[e2]) * 0.125f * fexp(bb[2 * e2 + 1]));
                ko[e2] = pk2(bflo(kw[e2]) * fexp(-bb[2 * e2]), bfhi(kw[e2]) * fexp(-bb[2 * e2 + 1])); }
            *(LAS u32x4*)(QT + t * 264 + 64 * j + 8 * c) = (u32x4){qo[0], qo[1], qo[2], qo[3]};
            *(LAS u32x4*)(KT + t * 264 + 64 * j + 8 * c) = (u32x4){ko[0], ko[1], ko[2], ko[3]};
        }
    }
    __syncthreads();
    gla_put_v(lds, tid, vv);
    const int h = w >> 1, eh = w & 1;
    f32x4 at[4][2];
#pragma unroll
    for (int a = 0; a < 4; ++a)
#pragma unroll
        for (int b = 0; b < 2; ++b) at[a][b] = (f32x4){0.f, 0.f, 0.f, 0.f};
#pragma unroll
    for (int ks = 0; ks < 2; ++ks) {
        bf16x8 af[4], bf[2];
#pragma unroll
        for (int mj = 0; mj < 4; ++mj) af[mj] = *(const LAS bf16x8*)(lds + GL_KT + ((16 * mj + fr) * 264 + h * 64 + 32 * ks + 8 * g) * 2);
#pragma unroll
        for (int ni = 0; ni < 2; ++ni) bf[ni] = *(const LAS bf16x8*)(lds + GL_QT + ((32 * eh + 16 * ni + fr) * 264 + h * 64 + 32 * ks + 8 * g) * 2);
#pragma unroll
        for (int mj = 0; mj < 4; ++mj)
#pragma unroll
            for (int ni = 0; ni < 2; ++ni) at[mj][ni] = MFMA16(af[mj], bf[ni], at[mj][ni]);
    }
    f32x4 acc[4][4];
#pragma unroll
    for (int a = 0; a < 4; ++a)
#pragma unroll
        for (int b = 0; b < 4; ++b) acc[a][b] = (f32x4){0.f, 0.f, 0.f, 0.f};
    const bf16_t* Sg = p.ST + ((size_t)(bl * 4 + h) * 64 + n) * 8192;
#pragma unroll
    for (int ks = 0; ks < 2; ++ks) {
        bf16x8 af[4], bf[4];
#pragma unroll
        for (int me = 0; me < 4; ++me) af[me] = *(const bf16x8*)(Sg + (size_t)(64 * eh + 32 * (me >> 1) + 4 * (me & 1) + 8 * (fr >> 2) + (fr & 3)) * 64 + 32 * ks + 8 * g);
#pragma unroll
        for (int ni = 0; ni < 4; ++ni) bf[ni] = *(const LAS bf16x8*)(lds + GL_QT + ((16 * ni + fr) * 264 + h * 64 + 32 * ks + 8 * g) * 2);
#pragma unroll
        for (int me = 0; me < 4; ++me)
#pragma unroll
            for (int ni = 0; ni < 4; ++ni) acc[me][ni] = MFMA16(af[me], bf[ni], acc[me][ni]);
    }
    __syncthreads();
    {
        LAS unsigned char* AT = lds + GL_QT + h * 9216;
#pragma unroll
        for (int mj = 0; mj < 4; ++mj)
#pragma unroll
            for (int ni = 0; ni < 2; ++ni) { const int i = 32 * eh + 16 * ni + fr, j0 = 16 * mj + 4 * g;
                float v[4];
#pragma unroll
                for (int r = 0; r < 4; ++r) v[r] = (j0 + r <= i) ? at[mj][ni][r] : 0.f;
                u32x2 o; o.x = pk2(v[0], v[1]); o.y = pk2(v[2], v[3]); *(LAS u32x2*)(AT + (i * 72 + j0) * 2) = o; }
    }
    __syncthreads();
#pragma unroll
    for (int ks = 0; ks < 2; ++ks) {
        bf16x8 af[4], bf[4];
#pragma unroll
        for (int me = 0; me < 4; ++me) af[me] = gla_vfrag<GL_VT, GL_VS, 8>(lds, h * 128 + 64 * eh + 32 * (me >> 1) + 4 * (me & 1), ks, lane);
#pragma unroll
        for (int ni = 0; ni < 4; ++ni) bf[ni] = *(const LAS bf16x8*)(lds + GL_QT + h * 9216 + ((16 * ni + fr) * 72 + 32 * ks + 8 * g) * 2);
#pragma unroll
        for (int me = 0; me < 4; ++me)
#pragma unroll
            for (int ni = 0; ni < 4; ++ni) acc[me][ni] = MFMA16(af[me], bf[ni], acc[me][ni]);
    }
    u32x4 zc[4][2];
#pragma unroll
    for (int ni = 0; ni < 4; ++ni)
#pragma unroll
        for (int a2 = 0; a2 < 2; ++a2) zc[ni][a2] = *(const u32x4*)(p.Y + (size_t)(r0 + 16 * ni + fr) * YW + Y_ZC + h * 128 + 64 * eh + 32 * a2 + 8 * g);
    __builtin_amdgcn_sched_barrier(0);
    float og[4][4];
#pragma unroll
    for (int me = 0; me < 4; ++me) { const f32x4 t4 = *(const f32x4*)(p.o_g + l * 128 + 64 * eh + 32 * (me >> 1) + 8 * g + 4 * (me & 1)); og[me][0] = t4[0]; og[me][1] = t4[1]; og[me][2] = t4[2]; og[me][3] = t4[3]; }
    LAS float* red = (LAS float*)(lds + GL_G);
#pragma unroll
    for (int ni = 0; ni < 4; ++ni) { float ss = 0.f;
#pragma unroll
        for (int me = 0; me < 4; ++me) ss += (acc[me][ni][0] * acc[me][ni][0] + acc[me][ni][1] * acc[me][ni][1]) + (acc[me][ni][2] * acc[me][ni][2] + acc[me][ni][3] * acc[me][ni][3]);
        ss += __shfl_xor(ss, 16); ss += __shfl_xor(ss, 32);
        if (g == 0) red[w * 64 + 16 * ni + fr] = ss; }
    __syncthreads();
#pragma unroll
    for (int ni = 0; ni < 4; ++ni) { const int i = 16 * ni + fr;
        const float rr = t_rsq((red[w * 64 + i] + red[(w ^ 1) * 64 + i]) * (1.0f / 128.0f) + EPS);
        bf16_t* yo = p.Y + (size_t)(r0 + i) * YW + Y_ZC + h * 128 + 64 * eh + 8 * g;
        bf16_t* yw = DRY ? p.merged + (size_t)(r0 + i) * D + 512 + h * 128 + 64 * eh + 8 * g : yo;
#pragma unroll
        for (int a2 = 0; a2 < 2; ++a2) { const u32x4 z = zc[ni][a2]; const f32x4 c0 = acc[2 * a2][ni], c1 = acc[2 * a2 + 1][ni];
            u32x4 o; o.x = pk2(c0[0] * rr * og[2 * a2][0] * bflo(z.x), c0[1] * rr * og[2 * a2][1] * bfhi(z.x)); o.y = pk2(c0[2] * rr * og[2 * a2][2] * bflo(z.y), c0[3] * rr * og[2 * a2][3] * bfhi(z.y));
            o.z = pk2(c1[0] * rr * og[2 * a2 + 1][0] * bflo(z.z), c1[1] * rr * og[2 * a2 + 1][1] * bfhi(z.z)); o.w = pk2(c1[2] * rr * og[2 * a2 + 1][2] * bflo(z.w), c1[3] * rr * og[2 * a2 + 1][3] * bfhi(z.w));
            *(u32x4*)(yw + 32 * a2) = o; } }
    __syncthreads();
}

constexpr int SG_STR = 136;
constexpr int SG_RS = 1056;
static_assert(128 * SG_RS <= 512 * SG_STR * 2, "SG image");
constexpr int SG_LN = 512 * SG_STR * 2;
static_assert(SG_LN + 4096 <= LDS_BARW, "SG LDS map");
__device__ __forceinline__ void sg_unit(const P& p, int l, int un, ldsp lds, bool DRY) {
    int tid = threadIdx.x; asm volatile("" : "+v"(tid) :: "memory");
    const int lane = tid & 63, fr = lane & 15, g = lane >> 4; const int w = __builtin_amdgcn_readfirstlane(tid >> 6);
    const int r0 = un * 128;
    {
        const int j = tid >> 2, qd = tid & 3;
        const bf16_t* src = p.Y + (size_t)(r0 + j) * YW + Y_GV + 128 * qd;
        if (tid < 128) *(LAS f32x4*)(lds + SG_LN + tid * 16) = *(const f32x4*)(p.sg_ln_g + l * 512 + 4 * tid);
        else if (tid < 256) *(LAS f32x4*)(lds + SG_LN + 2048 + (tid - 128) * 16) = *(const f32x4*)(p.sg_ln_b + l * 512 + 4 * (tid - 128));
        u32x4 x[16]; float s = 0.f;
#pragma unroll
        for (int i = 0; i < 16; ++i) { x[i] = *(const u32x4*)(src + 8 * i); s += (bflo(x[i].x) + bfhi(x[i].x)) + (bflo(x[i].y) + bfhi(x[i].y)) + (bflo(x[i].z) + bfhi(x[i].z)) + (bflo(x[i].w) + bfhi(x[i].w)); }
        s += __shfl_xor(s, 1); s += __shfl_xor(s, 2);
        const float mu = s * (1.0f / 512.0f); float q = 0.f;
#pragma unroll
        for (int i = 0; i < 16; ++i) { float d;
            d = bflo(x[i].x) - mu; q += d * d; d = bfhi(x[i].x) - mu; q += d * d; d = bflo(x[i].y) - mu; q += d * d; d = bfhi(x[i].y) - mu; q += d * d;
            d = bflo(x[i].z) - mu; q += d * d; d = bfhi(x[i].z) - mu; q += d * d; d = bflo(x[i].w) - mu; q += d * d; d = bfhi(x[i].w) - mu; q += d * d; }
        q += __shfl_xor(q, 1); q += __shfl_xor(q, 2);
        const float rs = t_rsq(q * (1.0f / 512.0f) + EPS);
        __syncthreads();
        const LAS float* lg = (const LAS float*)(lds + SG_LN) + 128 * qd; const LAS float* lb = (const LAS float*)(lds + SG_LN + 2048) + 128 * qd;
#pragma unroll
        for (int i = 0; i < 16; ++i) {
            const f32x4 g0 = *(const LAS f32x4*)(lg + 8 * i), g1 = *(const LAS f32x4*)(lg + 8 * i + 4), b0 = *(const LAS f32x4*)(lb + 8 * i), b1 = *(const LAS f32x4*)(lb + 8 * i + 4);
            u32x4 o;
            o.x = pk2((bflo(x[i].x) - mu) * rs * g0[0] + b0[0], (bfhi(x[i].x) - mu) * rs * g0[1] + b0[1]); o.y = pk2((bflo(x[i].y) - mu) * rs * g0[2] + b0[2], (bfhi(x[i].y) - mu) * rs * g0[3] + b0[3]);
            o.z = pk2((bflo(x[i].z) - mu) * rs * g1[0] + b1[0], (bfhi(x[i].z) - mu) * rs * g1[1] + b1[1]); o.w = pk2((bflo(x[i].w) - mu) * rs * g1[2] + b1[2], (bfhi(x[i].w) - mu) * rs * g1[3] + b1[3]);
            *(LAS u32x4*)(lds + j * SG_RS + (128 * qd + 8 * i) * 2) = o;
        }
    }
    __syncthreads();
    const int gq = w >> 1, ch = w & 1;
    const bf16_t* Wg = p.sgw + ((size_t)l * 4 + gq) * 128 * 128;
#pragma unroll
    for (int ps = 0; ps < 2; ++ps) {
        f32x4 acc[4][4];
#pragma unroll
        for (int a = 0; a < 4; ++a)
#pragma unroll
            for (int b = 0; b < 4; ++b) acc[a][b] = (f32x4){0.f, 0.f, 0.f, 0.f};
        u32x4 zu[4][2];
#pragma unroll
        for (int ni = 0; ni < 4; ++ni)
#pragma unroll
            for (int a2 = 0; a2 < 2; ++a2) zu[ni][a2] = *(const u32x4*)(p.Y + (size_t)(r0 + 64 * ps + 16 * ni + fr) * YW + Y_UZ + 128 * gq + 64 * ch + 32 * a2 + 8 * g);
        float bsv[4];
#pragma unroll
        for (int ni = 0; ni < 4; ++ni) bsv[ni] = p.sg_b[(l * 4 + gq) * 128 + 64 * ps + 16 * ni + fr];
        __builtin_amdgcn_sched_barrier(0);
        const int nks = ps ? 4 : 2;
#pragma unroll
        for (int ks = 0; ks < nks; ++ks) {
            bf16x8 af[4], bf[4];
#pragma unroll
            for (int mc = 0; mc < 4; ++mc) af[mc] = gla_vfrag<0, SG_RS, 8>(lds, 128 * gq + 64 * ch + 32 * (mc >> 1) + 4 * (mc & 1), ks, lane);
#pragma unroll
            for (int ni = 0; ni < 4; ++ni) bf[ni] = *(const bf16x8*)(Wg + (size_t)(64 * ps + 16 * ni + fr) * 128 + 32 * ks + 8 * g);
#pragma unroll
            for (int mc = 0; mc < 4; ++mc)
#pragma unroll
                for (int ni = 0; ni < 4; ++ni) acc[mc][ni] = MFMA16(af[mc], bf[ni], acc[mc][ni]);
        }
#pragma unroll
        for (int ni = 0; ni < 4; ++ni) { const int i = 64 * ps + 16 * ni + fr; const float bs = bsv[ni];
            bf16_t* yo = p.Y + (size_t)(r0 + i) * YW + Y_UZ + 128 * gq + 64 * ch + 8 * g;
            bf16_t* yw = DRY ? p.merged + (size_t)(r0 + i) * D + 128 * gq + 64 * ch + 8 * g : yo;
#pragma unroll
            for (int a2 = 0; a2 < 2; ++a2) { const u32x4 z = zu[ni][a2]; const f32x4 c0 = acc[2 * a2][ni], c1 = acc[2 * a2 + 1][ni];
                u32x4 o; o.x = pk2((c0[0] + bs) * bflo(z.x), (c0[1] + bs) * bfhi(z.x)); o.y = pk2((c0[2] + bs) * bflo(z.y), (c0[3] + bs) * bfhi(z.y));
                o.z = pk2((c1[0] + bs) * bflo(z.z), (c1[1] + bs) * bfhi(z.z)); o.w = pk2((c1[2] + bs) * bflo(z.w), (c1[3] + bs) * bfhi(z.w));
                *(u32x4*)(yw + 32 * a2) = o; } }
    }
    __syncthreads();
}

__device__ __forceinline__ void attn_unit(const P& p, int bh, int qb, ldsp lds, bool DRY) {
    int tid = threadIdx.x; asm volatile("" : "+v"(tid) :: "memory");
    const int lane = tid & 63, r32 = lane & 31, hi = lane >> 5; const int w = __builtin_amdgcn_readfirstlane(tid >> 6);
    const bf16_t* Qh = p.Q + (size_t)bh * S * 96; const bf16_t* Kh = p.K + (size_t)bh * S * 96; const bf16_t* Vh = p.V + (size_t)bh * S * 64;
    const int q0 = qb * 256 + 32 * w, NT = 4 * qb + 4, tlast = 4 * qb + (w >> 1);
    bf16x8 qf[6];
#pragma unroll
    for (int d0 = 0; d0 < 6; ++d0) qf[d0] = *(const bf16x8*)(Qh + (size_t)(q0 + r32) * 96 + 16 * d0 + 8 * hi);
    const int kk0 = 16 * (w & 3) + (lane >> 2), kc0 = 4 * (w >> 2) + (lane & 3), kk1 = 16 * (w & 3) + (lane >> 2), kc1 = 8 + (lane & 3);
    const bf16_t* ks0 = Kh + (size_t)kk0 * 96 + kc0 * 8; const bf16_t* ks1 = Kh + (size_t)kk1 * 96 + kc1 * 8; const bf16_t* vs = Vh + (size_t)(tid >> 3) * 64 + (tid & 7) * 8;
    const int kd0 = kc0 * 1024 + kk0 * 16, kd1 = kc1 * 1024 + kk1 * 16, vd = 12288 + ((tid & 7) >> 2) * 4096 + (tid >> 3) * 64 + (tid & 3) * 16;
    const bool two = tid < 256;
    u32x4 ak0, ak1 = (u32x4){0u, 0u, 0u, 0u}, av, bk0, bk1 = (u32x4){0u, 0u, 0u, 0u}, bv;
#define ATT_LOAD(K0, K1, V, tt) do { const size_t ko_ = (size_t)(tt) * 64 * 96, vo_ = (size_t)(tt) * 64 * 64; K0 = *(const u32x4*)(ks0 + ko_); if (two) K1 = *(const u32x4*)(ks1 + ko_); V = *(const u32x4*)(vs + vo_); } while (0)
#define ATT_WRITE(K0, K1, V, bo) do { *(LAS u32x4*)(lds + (bo) + kd0) = K0; if (two) *(LAS u32x4*)(lds + (bo) + kd1) = K1; *(LAS u32x4*)(lds + (bo) + vd) = V; } while (0)
    ATT_LOAD(ak0, ak1, av, 0); ATT_LOAD(bk0, bk1, bv, 1);
    if (w < 4) __builtin_amdgcn_s_setprio(2);
    ATT_WRITE(ak0, ak1, av, 0);
    __syncthreads();
    f32x16 o0, o1;
#pragma unroll
    for (int r = 0; r < 16; ++r) { o0[r] = 0.f; o1[r] = 0.f; }
    f32x16 lacc;
#pragma unroll
    for (int r = 0; r < 16; ++r) lacc[r] = 0.f;
    const bf16x8 ones8 = (bf16x8){(short)0x3f80, (short)0x3f80, (short)0x3f80, (short)0x3f80, (short)0x3f80, (short)0x3f80, (short)0x3f80, (short)0x3f80};
    float mref = 0.f, lrun = 0.f;
    f32x16 negm;
#pragma unroll
    for (int r = 0; r < 16; ++r) negm[r] = 0.f;
    const int vb = 12288 + ((lane >> 4) & 1) * 32 + (lane & 3) * 8 + (4 * hi + ((lane & 15) >> 2)) * 64;
#define ATT_STEP(t, cur) do { \
            if (t <= tlast) { \
                bf16x8 kf[12]; \
    _Pragma("unroll") \
                for (int i = 0; i < 12; ++i) kf[i] = *(const LAS bf16x8*)(lds + cur + (2 * (i >> 1) + hi) * 1024 + (i & 1) * 512 + r32 * 16);     \
                __builtin_amdgcn_sched_barrier(0); \
                f32x16 p0 = MFMA32(kf[0], qf[0], negm), p1 = MFMA32(kf[1], qf[0], negm); \
    _Pragma("unroll") \
                for (int d0 = 1; d0 < 6; ++d0) { p0 = MFMA32(kf[2 * d0], qf[d0], p0); p1 = MFMA32(kf[2 * d0 + 1], qf[d0], p1); } \
                s16x4 vf[16];                                                \
    _Pragma("unroll") \
                for (int ks = 0; ks < 4; ++ks) { \
                    vf[4 * ks + 0] = __builtin_bit_cast(s16x4, __builtin_amdgcn_ds_read_tr16_b64_v4i16((LAS v4i16_t*)(lds + cur + vb + ks * 1024))); \
                    vf[4 * ks + 1] = __builtin_bit_cast(s16x4, __builtin_amdgcn_ds_read_tr16_b64_v4i16((LAS v4i16_t*)(lds + cur + vb + ks * 1024 + 512))); \
                    vf[4 * ks + 2] = __builtin_bit_cast(s16x4, __builtin_amdgcn_ds_read_tr16_b64_v4i16((LAS v4i16_t*)(lds + cur + vb + 4096 + ks * 1024))); \
                    vf[4 * ks + 3] = __builtin_bit_cast(s16x4, __builtin_amdgcn_ds_read_tr16_b64_v4i16((LAS v4i16_t*)(lds + cur + vb + 4096 + ks * 1024 + 512))); \
                } \
                __builtin_amdgcn_sched_barrier(0); \
                float mxa = fmaxf(fmaxf(p0[0], p0[1]), p1[0]), mxb = fmaxf(fmaxf(p0[2], p0[3]), p1[1]); mxa = fmaxf(fmaxf(mxa, p1[2]), p1[3]); \
    _Pragma("unroll") \
                for (int r = 4; r < 16; r += 4) { mxa = fmaxf(fmaxf(mxa, p0[r]), p0[r + 1]); mxb = fmaxf(fmaxf(mxb, p0[r + 2]), p0[r + 3]); mxa = fmaxf(fmaxf(mxa, p1[r]), p1[r + 1]); mxb = fmaxf(fmaxf(mxb, p1[r + 2]), p1[r + 3]); } \
                float mx = fmaxf(mxa, mxb); { const auto rr_ = __builtin_amdgcn_permlane32_swap(__float_as_uint(mx), __float_as_uint(mx), false, false); mx = fmaxf(__uint_as_float(rr_[0]), __uint_as_float(rr_[1])); }     \
                if (__builtin_expect((t) == 0 || __any(mx > 8.0f), 0)) {       \
                    const float dl = ((t) == 0) ? mx : fmaxf(mx, 0.f), f = t_exp2(-dl); mref += dl; \
    _Pragma("unroll") \
                    for (int r = 0; r < 16; ++r) { p0[r] -= dl; p1[r] -= dl; negm[r] = -mref; o0[r] *= f; o1[r] *= f; lacc[r] *= f; } \
                } \
    _Pragma("unroll") \
                for (int r = 0; r < 16; ++r) { p0[r] = t_exp2(p0[r]); p1[r] = t_exp2(p1[r]); } \
                u32x4 pw[4]; \
                pw[0] = (u32x4){pk2(p0[0], p0[1]), pk2(p0[2], p0[3]), pk2(p0[4], p0[5]), pk2(p0[6], p0[7])}; \
                pw[1] = (u32x4){pk2(p0[8], p0[9]), pk2(p0[10], p0[11]), pk2(p0[12], p0[13]), pk2(p0[14], p0[15])}; \
                pw[2] = (u32x4){pk2(p1[0], p1[1]), pk2(p1[2], p1[3]), pk2(p1[4], p1[5]), pk2(p1[6], p1[7])}; \
                pw[3] = (u32x4){pk2(p1[8], p1[9]), pk2(p1[10], p1[11]), pk2(p1[12], p1[13]), pk2(p1[14], p1[15])}; \
    _Pragma("unroll") \
                for (int ks = 0; ks < 4; ++ks) { \
                    const bf16x8 pf = __builtin_bit_cast(bf16x8, pw[ks]); \
                    const s16x4 a0 = vf[4 * ks], a1 = vf[4 * ks + 1], b0 = vf[4 * ks + 2], b1 = vf[4 * ks + 3]; \
                    const bf16x8 va = (bf16x8){a0[0], a0[1], a0[2], a0[3], a1[0], a1[1], a1[2], a1[3]}, vbb = (bf16x8){b0[0], b0[1], b0[2], b0[3], b1[0], b1[1], b1[2], b1[3]}; \
                    o0 = MFMA32(va, pf, o0); o1 = MFMA32(vbb, pf, o1); lacc = MFMA32(ones8, pf, lacc); \
                } \
            } \
    } while (0)
    for (int t0 = 0; t0 < NT; t0 += 2) {
        if (t0 + 2 < NT) ATT_LOAD(ak0, ak1, av, t0 + 2);
        ATT_STEP(t0, 0);
        ATT_WRITE(bk0, bk1, bv, 20480);
        asm volatile("s_waitcnt lgkmcnt(0)\n\ts_barrier" ::: "memory");
        if (t0 + 3 < NT) ATT_LOAD(bk0, bk1, bv, t0 + 3);
        ATT_STEP(t0 + 1, 20480);
        if (t0 + 2 < NT) ATT_WRITE(ak0, ak1, av, 0);
        asm volatile("s_waitcnt lgkmcnt(0)\n\ts_barrier" ::: "memory");
    }
    __builtin_amdgcn_s_setprio(0);
#undef ATT_LOAD
#undef ATT_WRITE
#undef ATT_STEP
    lrun = lacc[0];
    const float il = t_rcp(lrun);
    const int bl = bh >> 3, h = bh & 7;
    const bf16_t* yrow = p.Y + (size_t)(bl * S + q0 + r32) * YW + Y_ZB + h * 64 + 8 * hi;
    bf16_t* wrow = DRY ? p.merged + (size_t)(bl * S + q0 + r32) * D + h * 64 + 8 * hi : p.Y + (size_t)(bl * S + q0 + r32) * YW + Y_ZB + h * 64 + 8 * hi;
    u32x4 zz[2][2];
#pragma unroll
    for (int dh = 0; dh < 2; ++dh)
#pragma unroll
        for (int pr = 0; pr < 2; ++pr) zz[dh][pr] = *(const u32x4*)(yrow + 32 * dh + 16 * pr);
    __builtin_amdgcn_sched_barrier(0);
#pragma unroll
    for (int dh = 0; dh < 2; ++dh)
#pragma unroll
        for (int pr = 0; pr < 2; ++pr) {
            float A[4], B[4];
#pragma unroll
            for (int j = 0; j < 4; ++j) { const float x = dh ? o1[8 * pr + j] : o0[8 * pr + j], y = dh ? o1[8 * pr + 4 + j] : o0[8 * pr + 4 + j];
                const auto r = __builtin_amdgcn_permlane32_swap(__float_as_uint(x), __float_as_uint(y), false, false); A[j] = __uint_as_float(r[0]); B[j] = __uint_as_float(r[1]); }
            const u32x4 z = zz[dh][pr]; u32x4 o;
            o.x = pk2(A[0] * il * bflo(z.x), A[1] * il * bfhi(z.x)); o.y = pk2(A[2] * il * bflo(z.y), A[3] * il * bfhi(z.y));
            o.z = pk2(B[0] * il * bflo(z.z), B[1] * il * bfhi(z.z)); o.w = pk2(B[2] * il * bflo(z.w), B[3] * il * bfhi(z.w));
            *(u32x4*)(wrow + 32 * dh + 16 * pr) = o;
        }
}
}

namespace fx {
template <int PH> __device__ __forceinline__ void run_phase(const P& p, int l, int sl, ldsp lds, bool DRY = false, int half = -1, int part = 3) {
    const int G = gridDim.x, bx = blockIdx.x;
    const int TH = (half < 0) ? T : T / 2, rofs = (half == 1) ? T / 2 : 0;
    if constexpr (PH == 0) { p0_prologue(p, lds); }
    if constexpr (PH == 2) {
        pg8::Gemm g{p.xb + ((size_t)sl * T + rofs) * D, p.Win_t + (size_t)l * NP * D, D, D, (DRY && FX_TIME_PH == 22) ? D / 2 : D, 0, 0, (DRY && FX_TIME_PH == 23) ? 0 : -1};
        pg8::StaticOrder So; So.init(TH, NP, G, bx);
        EpiIn E{p.Y + (size_t)rofs * YW, p.rstd + (size_t)sl * T + rofs, p.b_gate + l * 3 * D, p.GT + (size_t)(rofs / 256) * 12 * 16 * 512};
        pg8::gemm_phase<EpiIn, pg8::StaticOrder>(lds, g, So, E);
    }
    if constexpr (PH == 3) {
        if (half <= 0) { if (sl > 0) { if (l + 1 < DEPTH) p8_rstd(p, sl - 1); } else if (l > 0) p8_rstd(p, NSL - 1); }
        if (part & 1)
        for (int rp = (FX_TIME_PH == 31) ? 1 : 0; rp >= 0; --rp)
        mla_units128(p, l, sl, rofs / 128 + bx, G, (rofs + TH) / 128, lds);
        if (part & 2)
        for (int rp = (FX_TIME_PH == 32) ? 1 : 0; rp >= 0; --rp)
        for (int u = rofs / 64 + bx; u < (rofs + TH) / 64; u += G) { if (FX_SYNCU & 2) __syncthreads(); gla_a_unit(p, l, u, lds); }
    }
    if constexpr (PH == 4) {
        for (int rp = (FX_TIME_PH == 41) ? 1 : 0; rp >= 0; --rp)
        if (half <= 0) gla_scan(p);
        const int vcu = (G % 8 == 0) ? (bx % 8) * (G / 8) + bx / 8 : bx;
        for (int pr = (half == 1 ? SLB * 32 : 0) + vcu; pr < ((half == 0) ? SLB * 32 : SLB * 64); pr += G) {
            const int bh = pr >> 3, s = pr & 7;
            attn_unit(p, bh, s, lds, DRY); attn_unit(p, bh, 15 - s, lds, DRY);
        }
    }
    if constexpr (PH == 5) {
        for (int rp = (FX_TIME_PH == 51) ? 1 : 0; rp >= 0; --rp)
        for (int u = rofs / 64 + bx; u < (rofs + TH) / 64; u += G) gla_b_unit(p, l, u, lds, DRY || rp);
        for (int rp = (FX_TIME_PH == 52) ? 1 : 0; rp >= 0; --rp)
        for (int u = rofs / 128 + bx; u < (rofs + TH) / 128; u += G) sg_unit(p, l, u, lds, DRY || rp);
    }
    if constexpr (PH == 6) {
        pg8::Gemm g{p.Y + (size_t)rofs * YW, p.Wbr_t + (size_t)l * 3 * D * 512, YW, 512, 512, 1536 * 2, (long)D * 512 * 2};
        pg8::StaticOrderT<3> So; So.init(TH, D, G, bx);
        EpiMerge E{p.GT + (size_t)(rofs / 256) * 12 * 16 * 512, p.merged + (size_t)rofs * D};
        pg8::gemm_phase<EpiMerge, pg8::StaticOrderT<3>>(lds, g, So, E);
    }
    if constexpr (PH == 7) {
        pg8::Gemm g{p.merged + (size_t)rofs * D, p.Wout_t + (size_t)l * D * D, D, D, D, 0, 0};
        pg8::StaticOrder So; So.init(TH, D, G, bx);
        const size_t ro = (size_t)sl * T + rofs;
        EpiOut E{p.x_in + ro * D, DRY ? (float*)p.Q : p.out + ro * D, p.xb + ro * D, DRY ? p.UT : p.xb + ro * D, DRY ? (float*)p.Y : p.ssq + ro * 128, 0, l == DEPTH - 1};
        pg8::gemm_phase<EpiOut, pg8::StaticOrder>(lds, g, So, E);
    }
}

template <int PH> __global__ void __launch_bounds__(512, 2) FX_NOPK k_ph(P p, int l, int sl, int dry, int half, int part) {
    extern __shared__ __attribute__((aligned(16))) unsigned char smem[];
    run_phase<PH>(p, l, sl, (ldsp)smem, dry != 0, half, part);
}

__global__ void __launch_bounds__(512, 2) FX_NOPK k_mega(P p) {
    extern __shared__ __attribute__((aligned(16))) unsigned char smem[];
    ldsp lds = (ldsp)smem;
    if (threadIdx.x < 4) ((LAS unsigned*)(lds + LDS_BARW))[threadIdx.x] = 0u;
    __syncthreads();
    XcdBarrier bar = xcd_barrier_post(p.bar, (volatile LAS unsigned*)(lds + LDS_BARW));
#define GRID_BAR() do { XcdBarrier b_ = bar; asm volatile("" : "+s"(b_.x)); xcd_barrier(b_); } while (0)
    run_phase<0>(p, 0, 0, lds); GRID_BAR();
    for (int l = 0; l < DEPTH; ++l) {
        for (int sl = 0; sl < NSL; ++sl) {
            run_phase<2>(p, l, sl, lds); GRID_BAR();
            run_phase<3>(p, l, sl, lds); GRID_BAR();
            run_phase<4>(p, l, sl, lds); GRID_BAR();
            run_phase<5>(p, l, sl, lds); GRID_BAR();
            run_phase<6>(p, l, sl, lds); GRID_BAR();
            run_phase<7>(p, l, sl, lds);
        }
    }
}
}


extern "C" void kernel_launch(void* const* d_in, const int* in_sizes, int n_in, void* d_out, int out_size, void* d_ws, size_t ws_size, hipStream_t stream) {
    using namespace fx;
    static int grid = 0;
    if (grid == 0) {
        int dev = 0, cus = 0;
        if (hipGetDevice(&dev) != hipSuccess || hipDeviceGetAttribute(&cus, hipDeviceAttributeMultiprocessorCount, dev) != hipSuccess) { fprintf(stderr, "kernel_launch: device query failed\n"); grid = -1; return; }
        hipError_t e = hipFuncSetAttribute((const void*)k_mega, hipFuncAttributeMaxDynamicSharedMemorySize, LDS_BYTES);
        if (e != hipSuccess) { fprintf(stderr, "kernel_launch: hipFuncSetAttribute failed\n"); grid = -1; return; }
        int occ = 0;
        if (hipOccupancyMaxActiveBlocksPerMultiprocessor(&occ, (const void*)k_mega, 512, LDS_BYTES) != hipSuccess || occ < 1) { fprintf(stderr, "kernel_launch: occupancy query failed\n"); grid = -1; return; }
        grid = cus;
    }
    if (grid < 0) return;
    size_t off = 0; unsigned char* ws = (unsigned char*)d_ws;
    auto take = [&](size_t n) { unsigned char* q = ws + off; off += (n + 255) & ~(size_t)255; return q; };
    P p{};
    p.x_in = (const float*)d_in[0]; p.pos = (const int*)d_in[1]; p.norm_g = (const float*)d_in[2]; p.w_in = (const float*)d_in[3]; p.b_gate = (const float*)d_in[4];
    p.sg_ln_g = (const float*)d_in[5]; p.sg_ln_b = (const float*)d_in[6]; p.sg_w = (const float*)d_in[7]; p.sg_b = (const float*)d_in[8];
    p.cq_g = (const float*)d_in[9]; p.ckv_g = (const float*)d_in[10]; p.w_uq = (const float*)d_in[11]; p.w_ukv = (const float*)d_in[12]; p.q_g = (const float*)d_in[13]; p.k_g = (const float*)d_in[14];
    p.w_gate = (const float*)d_in[15]; p.bg_gate = (const float*)d_in[16]; p.o_g = (const float*)d_in[17]; p.w_branch = (const float*)d_in[18]; p.w_out = (const float*)d_in[19];
    p.out = (float*)d_out;
    p.bar = (unsigned*)take(16384);
    p.xb = (bf16_t*)take((size_t)NB * S * D * 2); p.rstd = (float*)take((size_t)NB * S * 4); p.ssq = (float*)take((size_t)NB * S * 4 * 32 * 4);
    p.Y = (bf16_t*)take((size_t)T * YW * 2);
    p.Q = (bf16_t*)take((size_t)SLB * 8 * S * 96 * 2); p.K = (bf16_t*)take((size_t)SLB * 8 * S * 96 * 2); p.V = (bf16_t*)take((size_t)SLB * 8 * S * 64 * 2);
    p.UT = (bf16_t*)take((size_t)SLB * 4 * 64 * 8192 * 2); p.ST = (bf16_t*)take((size_t)SLB * 4 * 64 * 8192 * 2); p.dec = (float*)take((size_t)SLB * 4 * 64 * 64 * 4);
    p.merged = (bf16_t*)take((size_t)T * D * 2); p.GT = (pg8::u32x2*)take((size_t)T * 3 * D);
    p.Win_t = (bf16_t*)take((size_t)DEPTH * NP * D * 2); p.Wuq_t = (bf16_t*)take((size_t)DEPTH * 768 * 256 * 2); p.Wukv_t = (bf16_t*)take((size_t)DEPTH * 1024 * 128 * 2);
    p.Wbr_t = (bf16_t*)take((size_t)DEPTH * 3 * D * 512 * 2); p.Wout_t = (bf16_t*)take((size_t)DEPTH * D * D * 2); p.sgw = (bf16_t*)take((size_t)DEPTH * 4 * 128 * 128 * 2);
    p.cs = (float*)take((size_t)NB * S * 16 * 4); p.sn = (float*)take((size_t)NB * S * 16 * 4); p.wgp = (bf16_t*)take((size_t)DEPTH * 256 * 32 * 2);
    if (off > ws_size) { fprintf(stderr, "kernel_launch: workspace too small: need %zu have %zu\n", off, ws_size); return; }
    (void)hipMemsetAsync(p.bar, 0, 16384, stream);
    hipLaunchKernelGGL(k_mega, dim3(grid), dim3(512), LDS_BYTES, stream, p);
}
```
